# Optimizing an MI355X kernel written in HIP

```python
import math
import jax, jax.numpy as jnp
from jax import lax
import numpy as np

D_MODEL = 2048
BATCH = 2
SEQ = 4096
DEPTH = 2

N_A_LAYERS = (DEPTH + 1) // 2
N_B_LAYERS = DEPTH // 2
SB_HEADS = 16
SB_HEAD_DIM = D_MODEL // SB_HEADS
DIFF_HEADS = 8
DIFF_HEAD_DIM = D_MODEL // DIFF_HEADS // 2
DIFF_V_DIM = 2 * DIFF_HEAD_DIM
D_FF = -(-8 * D_MODEL // (3 * 256)) * 256
Q_BLOCK = 128
ROPE_THETA = 10000.0
EPS = 1e-6
LAMBDA_PARAM_STD = 0.1

kernel_name = "yoco_stickbreak_diffattn_hybrid"


def rmsnorm(x, g):
    x32 = x.astype(jnp.float32)
    y = x32 * lax.rsqrt(jnp.mean(x32 * x32, axis=-1, keepdims=True) + EPS)
    return (y * g.astype(jnp.float32)).astype(x.dtype)


def rope(x):
    S, d = x.shape[1], x.shape[-1]
    inv_freq = ROPE_THETA ** (-jnp.arange(0, d, 2, dtype=jnp.float32) / d)
    ang = jnp.arange(S, dtype=jnp.float32)[:, None] * inv_freq[None, :]
    ang = jnp.concatenate([ang, ang], axis=-1)
    bshape = (S,) + (1,) * (x.ndim - 3) + (d,)
    cos = jnp.cos(ang).reshape(bshape)
    sin = jnp.sin(ang).reshape(bshape)
    x32 = x.astype(jnp.float32)
    x1, x2 = x32[..., : d // 2], x32[..., d // 2:]
    rot = jnp.concatenate([-x2, x1], axis=-1)
    return (x32 * cos + rot * sin).astype(x.dtype)


def swiglu(h, w_gate_up, w_down):
    gu = h @ w_gate_up
    g, u = gu[..., :D_FF], gu[..., D_FF:]
    return (jax.nn.silu(g) * u) @ w_down


def stick_breaking_attention(q, k, v):
    B, S, H, d = q.shape
    nb = S // Q_BLOCK
    qh = q.transpose(0, 2, 1, 3).astype(jnp.float32) * (d ** -0.5)
    kh = k.transpose(0, 2, 1, 3).astype(jnp.float32)
    vh = v.transpose(0, 2, 1, 3).astype(jnp.float32)
    qb = qh.reshape(B, H, nb, Q_BLOCK, d).transpose(2, 0, 1, 3, 4)
    kpos = jnp.arange(S)

    def block(args):
        q_blk, start = args
        qpos = start + jnp.arange(Q_BLOCK)
        z = jnp.einsum('bhqd,bhkd->bhqk', q_blk, kh)
        mask = kpos[None, :] < qpos[:, None]
        log_beta = jax.nn.log_sigmoid(z)
        log_1m = jnp.where(mask, jax.nn.log_sigmoid(-z), 0.0)
        later = lax.cumsum(log_1m, axis=3, reverse=True) - log_1m
        a = jnp.where(mask, jnp.exp(log_beta + later), 0.0)
        return jnp.einsum('bhqk,bhkd->bhqd', a, vh)

    starts = jnp.arange(nb) * Q_BLOCK
    out = lax.map(block, (qb, starts))
    return out.transpose(1, 0, 3, 2, 4).reshape(B, S, H * d).astype(v.dtype)


def differential_attention(q, k, v, lam):
    B, S, H, _, d = q.shape
    dv = v.shape[-1]
    nb = S // Q_BLOCK
    qh = q.transpose(0, 2, 3, 1, 4).astype(jnp.float32) * (d ** -0.5)
    kh = k.transpose(0, 2, 3, 1, 4).astype(jnp.float32)
    vh = v.transpose(0, 2, 1, 3).astype(jnp.float32)
    qb = qh.reshape(B, H, 2, nb, Q_BLOCK, d).transpose(3, 0, 1, 2, 4, 5)
    kpos = jnp.arange(S)

    def block(args):
        q_blk, start = args
        qpos = start + jnp.arange(Q_BLOCK)
        s = jnp.einsum('bhcqd,bhckd->bhcqk', q_blk, kh)
        mask = kpos[None, :] <= qpos[:, None]
        p = jax.nn.softmax(jnp.where(mask, s, -jnp.inf), axis=-1)
        w = p[:, :, 0] - lam * p[:, :, 1]
        return jnp.einsum('bhqk,bhkv->bhqv', w, vh)

    starts = jnp.arange(nb) * Q_BLOCK
    out = lax.map(block, (qb, starts))
    return out.transpose(1, 0, 3, 2, 4).reshape(B, S, H, dv).astype(v.dtype)


def setup_inputs(seed: int = 0) -> dict:
    key = jax.random.key(seed)
    ks = jax.random.split(key, 24)
    D, F = D_MODEL, D_FF

    def dense(k, shape):
        return jax.random.normal(k, shape, jnp.float32) * (shape[-2] ** -0.5)

    def gain(k, shape):
        return 1.0 + 0.02 * jax.random.normal(k, shape, jnp.float32)

    def small(k, shape, std):
        return std * jax.random.normal(k, shape, jnp.float32)

    return {
        "x": jax.random.normal(ks[0], (BATCH, SEQ, D), jnp.float32),
        "a_attn_norm": gain(ks[1], (N_A_LAYERS, D)),
        "a_w_qkv": dense(ks[2], (N_A_LAYERS, D, 3 * SB_HEADS * SB_HEAD_DIM)),
        "a_w_o": dense(ks[3], (N_A_LAYERS, SB_HEADS * SB_HEAD_DIM, D)),
        "a_ffn_norm": gain(ks[4], (N_A_LAYERS, D)),
        "a_w_gate_up": dense(ks[5], (N_A_LAYERS, D, 2 * F)),
        "a_w_down": dense(ks[6], (N_A_LAYERS, F, D)),
        "kv_norm": gain(ks[7], (D,)),
        "w_kv": dense(ks[8], (D, DIFF_HEADS * 2 * DIFF_HEAD_DIM + DIFF_HEADS * DIFF_V_DIM)),
        "k_norm": gain(ks[9], (DIFF_HEAD_DIM,)),
        "b_attn_norm": gain(ks[10], (N_B_LAYERS, D)),
        "b_w_q": dense(ks[11], (N_B_LAYERS, D, DIFF_HEADS * 2 * DIFF_HEAD_DIM)),
        "b_q_norm": gain(ks[12], (N_B_LAYERS, DIFF_HEAD_DIM)),
        "b_lambda_q1": small(ks[13], (N_B_LAYERS, DIFF_HEAD_DIM), LAMBDA_PARAM_STD),
        "b_lambda_k1": small(ks[14], (N_B_LAYERS, DIFF_HEAD_DIM), LAMBDA_PARAM_STD),
        "b_lambda_q2": small(ks[15], (N_B_LAYERS, DIFF_HEAD_DIM), LAMBDA_PARAM_STD),
        "b_lambda_k2": small(ks[16], (N_B_LAYERS, DIFF_HEAD_DIM), LAMBDA_PARAM_STD),
        "b_subln": gain(ks[17], (N_B_LAYERS, DIFF_V_DIM)),
        "b_w_o": dense(ks[18], (N_B_LAYERS, DIFF_HEADS * DIFF_V_DIM, D)),
        "b_ffn_norm": gain(ks[19], (N_B_LAYERS, D)),
        "b_w_gate_up": dense(ks[20], (N_B_LAYERS, D, 2 * F)),
        "b_w_down": dense(ks[21], (N_B_LAYERS, F, D)),
    }


def reference(x, a_attn_norm, a_w_qkv, a_w_o, a_ffn_norm, a_w_gate_up, a_w_down,
              kv_norm, w_kv, k_norm,
              b_attn_norm, b_w_q, b_q_norm, b_lambda_q1, b_lambda_k1, b_lambda_q2, b_lambda_k2,
              b_subln, b_w_o, b_ffn_norm, b_w_gate_up, b_w_down):
    B, S, D = x.shape
    HD_SB = SB_HEADS * SB_HEAD_DIM
    HK = DIFF_HEADS * 2 * DIFF_HEAD_DIM

    for layer in range(DEPTH):
        if layer < N_A_LAYERS:
            i = layer
            h = rmsnorm(x, a_attn_norm[i])
            qkv = h @ a_w_qkv[i]
            q = qkv[..., :HD_SB].reshape(B, S, SB_HEADS, SB_HEAD_DIM)
            k = qkv[..., HD_SB:2 * HD_SB].reshape(B, S, SB_HEADS, SB_HEAD_DIM)
            v = qkv[..., 2 * HD_SB:].reshape(B, S, SB_HEADS, SB_HEAD_DIM)
            x = x + stick_breaking_attention(q, k, v) @ a_w_o[i]
            x = x + swiglu(rmsnorm(x, a_ffn_norm[i]), a_w_gate_up[i], a_w_down[i])
            if layer == N_A_LAYERS - 1:
                kv = rmsnorm(x, kv_norm) @ w_kv
                k_sh = kv[..., :HK].reshape(B, S, DIFF_HEADS, 2, DIFF_HEAD_DIM)
                k_sh = rope(rmsnorm(k_sh, k_norm))
                v_sh = kv[..., HK:].reshape(B, S, DIFF_HEADS, DIFF_V_DIM)
        else:
            i = layer - N_A_LAYERS
            lambda_init = 0.8 - 0.6 * math.exp(-0.3 * layer)
            h = rmsnorm(x, b_attn_norm[i])
            q = (h @ b_w_q[i]).reshape(B, S, DIFF_HEADS, 2, DIFF_HEAD_DIM)
            q = rope(rmsnorm(q, b_q_norm[i]))
            lam = (jnp.exp(jnp.sum(b_lambda_q1[i].astype(jnp.float32) * b_lambda_k1[i].astype(jnp.float32)))
                   - jnp.exp(jnp.sum(b_lambda_q2[i].astype(jnp.float32) * b_lambda_k2[i].astype(jnp.float32)))
                   + lambda_init)
            o = differential_attention(q, k_sh, v_sh, lam)
            o = rmsnorm(o, b_subln[i]) * (1.0 - lambda_init)
            x = x + o.reshape(B, S, DIFF_HEADS * DIFF_V_DIM) @ b_w_o[i]
            x = x + swiglu(rmsnorm(x, b_ffn_norm[i]), b_w_gate_up[i], b_w_down[i])
    return x
```

```cpp
#include <hip/hip_runtime.h>
#include <hip/hip_cooperative_groups.h>
#include <cstdio>
#include <cstdint>
#include <cmath>
namespace cg = cooperative_groups;
namespace pg8 {
#define PG8_LAS __attribute__((address_space(3)))
typedef unsigned short bf16_t;
typedef short bf16x8 __attribute__((ext_vector_type(8)));
typedef float f32x4 __attribute__((ext_vector_type(4)));
typedef unsigned u32x4 __attribute__((ext_vector_type(4)));
constexpr int BM = 256, BK = 64, HALF = 128, HTB = HALF * BK * 2  , STAGE_BYTES = 8 * HTB, NXCD = 8, WGM = 8;

__host__ __device__ __forceinline__ int lds_byte(int r, int c) { const int st = (r >> 4) * 2 + (c >> 5), rr = r & 15, cc = c & 31, ob = rr * 64 + cc * 2; return st * 1024 + (ob ^ (((ob >> 9) & 1) << 5)); }
__host__ __device__ __forceinline__ void stage_rc(int b, int& R, int& C) { const int st = b / 1024, sb = b % 1024, swz = sb ^ (((sb >> 9) & 1) << 5); R = (st >> 1) * 16 + swz / 64; C = (st & 1) * 32 + (swz % 64) / 2; }
__host__ __device__ __forceinline__ int perm32(int rho) { const int n = rho >> 4, i = rho & 15; return 8 * (i >> 2) + 4 * n + (i & 3); }

struct Unit { int pm, pn; };
struct Gemm { const bf16_t* A; const bf16_t* Bt; int M, N, K; };

struct StaticOrder {
    int nM, nN, nwg, G, c;
    __host__ __device__ void init(int M, int N, int G_, int c_) { nM = M / BM; nN = N / BM; nwg = nM * nN; G = G_; c = c_; }
    __host__ __device__ bool next(int i, Unit& u) const {
        const long L = (long)i * G + c; if (L >= nwg) return false;
        int wgid = (int)L; { const int q = nwg / NXCD, r = nwg % NXCD, xcd = wgid % NXCD, off = wgid / NXCD; wgid = (xcd < r ? xcd * (q + 1) : r * (q + 1) + (xcd - r) * q) + off; }
        const int nig = WGM * nN, gid = wgid / nig, fm = gid * WGM, gsz = (nM - fm) < WGM ? (nM - fm) : WGM;
        u.pm = fm + ((wgid % nig) % gsz); u.pn = (wgid % nig) / gsz; return true;
    }
    __device__ __forceinline__ void a_ready(const Unit&) const {}
    __device__ __forceinline__ void done(const Unit&) const {}
};

__device__ __forceinline__ unsigned cvt_pk_bf16(float lo, float hi) { unsigned r; asm volatile("v_cvt_pk_bf16_f32 %0, %1, %2" : "=v"(r) : "v"(lo), "v"(hi)); return r; }
typedef float f32x2 __attribute__((ext_vector_type(2)));
__device__ __forceinline__ f32x2 gelu_pk(f32x2 v) {
    const f32x2 av = __builtin_elementwise_abs(v), d = av * 0.2316418882f + 1.0f;
    f32x2 t; t.x = __builtin_amdgcn_rcpf(d.x); t.y = __builtin_amdgcn_rcpf(d.y);
    f32x2 q = t * 0.5307027145f + (-0.7265760135f); q = q * t + 0.7107068705f; q = q * t + (-0.142248368f); q = q * t + 0.127414796f; q = q * t;
    const f32x2 s = (v * v) * (-0.72134752044f);
    f32x2 e; e.x = __builtin_amdgcn_exp2f(s.x); e.y = __builtin_amdgcn_exp2f(s.y);
    const f32x2 m = v * (q * e), r = v - m;
    f32x2 o; o.x = v.x < 0.f ? m.x : r.x; o.y = v.y < 0.f ? m.y : r.y; return o;
}

template <int ACT  > struct EpiBf16 {
    static constexpr bool PERM = true, AFTER_DRAIN = false; static_assert(ACT == 0 || ACT == 1, "EpiBf16: ACT is 0 (none) or 1 (gelu_pk)");
    bf16_t* O; int ldc; const float* bias; int split_cols; size_t split_stride; float scale0;
    __device__ __forceinline__ void operator()(const f32x4 (&acc)[2][2][4][2], const Unit& u, int wr, int wc, int fr, int fq) const {
        const int row0 = u.pm * BM + wr * 64 + fr; int colt = u.pn * BM; bf16_t* base = O;
        float sc = 1.f; if (split_cols) { const int t = colt / split_cols; base += (size_t)t * split_stride; colt -= t * split_cols; if (t == 0) sc = scale0; }
        const int col0 = colt + wc * 32 + 8 * fq, bcol0 = u.pn * BM + wc * 32 + 8 * fq;
        f32x4 bv[2][2];
#pragma unroll
        for (int bj = 0; bj < 2; ++bj)
#pragma unroll
            for (int n = 0; n < 2; ++n) bv[bj][n] = bias ? *(const f32x4*)(bias + bcol0 + bj * HALF + 4 * n) : (f32x4){0.f, 0.f, 0.f, 0.f};
#pragma unroll
        for (int ai = 0; ai < 2; ++ai)
#pragma unroll
            for (int m = 0; m < 4; ++m) { bf16_t* rowp = base + (size_t)(row0 + ai * HALF + m * 16) * ldc + col0;
#pragma unroll
                for (int bj = 0; bj < 2; ++bj) { f32x4 v0 = acc[ai][bj][m][0] + bv[bj][0], v1 = acc[ai][bj][m][1] + bv[bj][1];
                    if (ACT == 1) { f32x2 a = gelu_pk((f32x2){v0[0], v0[1]}), b = gelu_pk((f32x2){v0[2], v0[3]}), c = gelu_pk((f32x2){v1[0], v1[1]}), d = gelu_pk((f32x2){v1[2], v1[3]});
                        v0 = (f32x4){a.x, a.y, b.x, b.y}; v1 = (f32x4){c.x, c.y, d.x, d.y}; }
                    v0 = v0 * sc; v1 = v1 * sc; u32x4 w; w.x = cvt_pk_bf16(v0[0], v0[1]); w.y = cvt_pk_bf16(v0[2], v0[3]); w.z = cvt_pk_bf16(v1[0], v1[1]); w.w = cvt_pk_bf16(v1[2], v1[3]);
                    *(u32x4*)(rowp + bj * HALF) = w; } }
    }
};
struct EpiRes {
    static constexpr bool PERM = false, AFTER_DRAIN = false;
    const float* base; float* out; int ldc;
    __device__ __forceinline__ void operator()(const f32x4 (&acc)[2][2][4][2], const Unit& u, int wr, int wc, int fr, int fq) const {
        const int row0 = u.pm * BM + wr * 64 + fr, col0 = u.pn * BM + wc * 32 + 4 * fq;
#pragma unroll
        for (int ai = 0; ai < 2; ++ai)
#pragma unroll
            for (int m = 0; m < 4; ++m) { const size_t off = (size_t)(row0 + ai * HALF + m * 16) * ldc + col0;
#pragma unroll
                for (int bj = 0; bj < 2; ++bj)
#pragma unroll
                    for (int n = 0; n < 2; ++n) { const f32x4 b = *(const f32x4*)(base + off + bj * HALF + n * 16); *(f32x4*)(out + off + bj * HALF + n * 16) = b + acc[ai][bj][m][n]; }  asm volatile("" ::: "memory"); }
    }
};
struct EpiSwiglu {
    static constexpr bool PERM = true, AFTER_DRAIN = false;
    bf16_t* O; int ldo;
    static __device__ __forceinline__ float sg(float g, float u) { return g * u * __builtin_amdgcn_rcpf(1.0f + __builtin_amdgcn_exp2f(-1.4426950408889634f * g)); }
    __device__ __forceinline__ void operator()(const f32x4 (&acc)[2][2][4][2], const Unit& u, int wr, int wc, int fr, int fq) const {
        const int row0 = u.pm * BM + wr * 64 + fr, col0 = u.pn * HALF + wc * 32 + 8 * fq;
#pragma unroll
        for (int ai = 0; ai < 2; ++ai)
#pragma unroll
            for (int m = 0; m < 4; ++m) { bf16_t* rowp = O + (size_t)(row0 + ai * HALF + m * 16) * ldo + col0;
                const f32x4 g0 = acc[ai][0][m][0], g1 = acc[ai][0][m][1], u0 = acc[ai][1][m][0], u1 = acc[ai][1][m][1];
                u32x4 w; w.x = cvt_pk_bf16(sg(g0[0], u0[0]), sg(g0[1], u0[1])); w.y = cvt_pk_bf16(sg(g0[2], u0[2]), sg(g0[3], u0[3]));
                w.z = cvt_pk_bf16(sg(g1[0], u1[0]), sg(g1[1], u1[1])); w.w = cvt_pk_bf16(sg(g1[2], u1[2]), sg(g1[3], u1[3]));
                *(u32x4*)rowp = w; }
    }
};

template <class Epi, class Sched, bool ALIGN_EPI = false, bool SP2 = false>
__device__ __forceinline__ void gemm_phase(PG8_LAS unsigned char* lds, const Gemm g, const Sched& S, const Epi& E) {
    int tid_ = threadIdx.x; asm volatile("" : "+v"(tid_));
    const int tid = tid_, wid = __builtin_amdgcn_readfirstlane(tid >> 6), lane = tid & 63, wr = wid >> 2, wc = wid & 3, fr = lane & 15, fq = lane >> 4;
    const int K = g.K, nt = K / BK;
    unsigned voffA[2], voffB[2];
#pragma unroll
    for (int i = 0; i < 2; ++i) { int R, C; stage_rc(tid * 16 + i * 8192, R, C); const int Rb = Epi::PERM ? ((R & ~31) + perm32(R & 31)) : R;
        voffA[i] = (unsigned)(R * K + C) * 2u; voffB[i] = (unsigned)(Rb * K + C) * 2u; }
    const size_t kstep = (size_t)(BK * 2);
    const size_t hstep = (size_t)HALF * K * 2;
    const size_t tstep = 2 * hstep;
    const unsigned ldsw = (unsigned)wid * 1024u;
    const int aoff = lds_byte(wr * 64 + fr, fq * 8), boff = lds_byte(wc * 32 + fr, fq * 8);
#define PG8_SA(b, h) (((b) * 2 + (h)) * HTB)
#define PG8_SB(b, h) ((4 + (b) * 2 + (h)) * HTB)
#define PG8_STAGE(bufoff, gbase, voff) do { _Pragma("unroll") for (int _i = 0; _i < 2; ++_i) \
        __builtin_amdgcn_global_load_lds((const unsigned*)((const char*)(gbase) + (voff)[_i]), (PG8_LAS unsigned*)(lds + (bufoff) + ldsw + _i * 8192), 16, 0, 0); } while (0)
#define PG8_LDA(dst, b, h) do { _Pragma("unroll") for (int m = 0; m < 4; ++m) _Pragma("unroll") for (int k = 0; k < 2; ++k) dst[m][k] = *(const PG8_LAS bf16x8*)(lds + PG8_SA(b, h) + aoff + m * 2048 + k * 1024); } while (0)
#define PG8_LDB(dst, b, h) do { _Pragma("unroll") for (int n = 0; n < 2; ++n) _Pragma("unroll") for (int k = 0; k < 2; ++k) dst[n][k] = *(const PG8_LAS bf16x8*)(lds + PG8_SB(b, h) + boff + n * 2048 + k * 1024); } while (0)
#define PG8_MMA(ai, bj, At, Bt) do { __builtin_amdgcn_s_setprio(1); _Pragma("unroll") for (int m = 0; m < 4; ++m) _Pragma("unroll") for (int n = 0; n < 2; ++n) _Pragma("unroll") for (int k = 0; k < 2; ++k) \
        acc[ai][bj][m][n] = __builtin_amdgcn_mfma_f32_16x16x32_bf16(Bt[n][k], At[m][k], acc[ai][bj][m][n], 0, 0, 0); __builtin_amdgcn_s_setprio(0); } while (0)
#define PG8_WAIT_V(n) asm volatile("s_waitcnt vmcnt(" #n ")" ::: "memory")
#define PG8_WAIT_L(n) asm volatile("s_waitcnt lgkmcnt(" #n ")" ::: "memory")
#define PG8_BAR __builtin_amdgcn_s_barrier()
#define PG8_SCHED __builtin_amdgcn_sched_barrier(0)
    Unit cur, nxt; int ui = 0;
    if (!S.next(0, cur)) return;
    f32x4 acc[2][2][4][2];
#pragma unroll
    for (int a = 0; a < 2; ++a)
#pragma unroll
        for (int b = 0; b < 2; ++b)
#pragma unroll
            for (int m = 0; m < 4; ++m)
#pragma unroll
                for (int n = 0; n < 2; ++n) acc[a][b][m][n] = (f32x4){0.f, 0.f, 0.f, 0.f};
    bf16x8 At[4][2], B0[2][2], B1[2][2];
    const char* cA = (const char*)g.A + (size_t)cur.pm * tstep; const char* cB = (const char*)g.Bt + (size_t)cur.pn * tstep;
    S.a_ready(cur);
    if constexpr (SP2) {
        PG8_STAGE(PG8_SB(0, 0), cB, voffB); PG8_STAGE(PG8_SB(0, 1), cB + hstep, voffB); PG8_STAGE(PG8_SA(0, 0), cA, voffA); PG8_STAGE(PG8_SA(0, 1), cA + hstep, voffA);
        if (wr == 1) PG8_BAR;
        PG8_WAIT_V(2); PG8_BAR;
        PG8_STAGE(PG8_SB(1, 0), cB + kstep, voffB); PG8_STAGE(PG8_SA(1, 0), cA + kstep, voffA); PG8_STAGE(PG8_SB(1, 1), cB + hstep + kstep, voffB);
        PG8_WAIT_V(6); PG8_BAR;
    } else {
        PG8_STAGE(PG8_SB(0, 0), cB, voffB); PG8_STAGE(PG8_SA(0, 0), cA, voffA); PG8_STAGE(PG8_SB(0, 1), cB + hstep, voffB); PG8_STAGE(PG8_SA(0, 1), cA + hstep, voffA);
        if (wr == 1) PG8_BAR;
        PG8_WAIT_V(4); PG8_BAR;
        PG8_STAGE(PG8_SB(1, 0), cB + kstep, voffB); PG8_STAGE(PG8_SA(1, 0), cA + kstep, voffA); PG8_STAGE(PG8_SB(1, 1), cB + hstep + kstep, voffB);
        PG8_WAIT_V(6); PG8_BAR;
    }
    for (;;) {
        const bool has_next = S.next(ui + 1, nxt);
        const char* nA = has_next ? (const char*)g.A + (size_t)nxt.pm * tstep : cA; const char* nB = has_next ? (const char*)g.Bt + (size_t)nxt.pn * tstep : cB;
        for (int t = 0; t < nt; t += 2) {
            const bool last = (t == nt - 2);
            const char* a1 = cA + (size_t)(t + 1) * kstep;
            const char* a2 = last ? nA : cA + (size_t)(t + 2) * kstep; const char* b2 = last ? nB : cB + (size_t)(t + 2) * kstep;
            const char* a3 = a2 + kstep; const char* b3 = b2 + kstep;
            if (last && has_next) S.a_ready(nxt);
            if constexpr (SP2) {
            PG8_LDB(B0, 0, 0); PG8_LDB(B1, 0, 1); PG8_SCHED; PG8_LDA(At, 0, 0); PG8_STAGE(PG8_SA(1, 1), a1 + hstep, voffA);
            PG8_WAIT_V(8); PG8_WAIT_L(0); PG8_BAR; PG8_MMA(0, 0, At, B0); PG8_MMA(0, 1, At, B1); PG8_BAR; PG8_SCHED;
            PG8_LDA(At, 0, 1); PG8_STAGE(PG8_SB(0, 0), b2, voffB); PG8_STAGE(PG8_SB(0, 1), b2 + hstep, voffB); PG8_STAGE(PG8_SA(0, 0), a2, voffA);
            PG8_WAIT_V(8); PG8_WAIT_L(0); PG8_BAR; PG8_MMA(1, 0, At, B0); PG8_MMA(1, 1, At, B1); PG8_BAR; PG8_SCHED;
            PG8_LDB(B0, 1, 0); PG8_LDB(B1, 1, 1); PG8_SCHED; PG8_LDA(At, 1, 0); PG8_STAGE(PG8_SA(0, 1), a2 + hstep, voffA);
            PG8_WAIT_V(8); PG8_WAIT_L(0); PG8_BAR; PG8_MMA(0, 0, At, B0); PG8_MMA(0, 1, At, B1); PG8_BAR; PG8_SCHED;
            PG8_LDA(At, 1, 1); PG8_STAGE(PG8_SB(1, 0), b3, voffB); PG8_STAGE(PG8_SB(1, 1), b3 + hstep, voffB); PG8_STAGE(PG8_SA(1, 0), a3, voffA);
            PG8_WAIT_V(8); PG8_WAIT_L(0); PG8_BAR; PG8_MMA(1, 0, At, B0); PG8_MMA(1, 1, At, B1); PG8_BAR; PG8_SCHED;
            } else {
            PG8_LDB(B0, 0, 0); PG8_SCHED; PG8_LDA(At, 0, 0); PG8_STAGE(PG8_SA(1, 1), a1 + hstep, voffA);
            PG8_WAIT_L(8); PG8_BAR; PG8_WAIT_L(0); PG8_MMA(0, 0, At, B0); PG8_BAR; PG8_SCHED;
            PG8_LDB(B1, 0, 1); PG8_STAGE(PG8_SB(0, 0), b2, voffB);
            PG8_BAR; PG8_WAIT_L(0); PG8_MMA(0, 1, At, B1); PG8_BAR;
            PG8_LDA(At, 0, 1); PG8_STAGE(PG8_SA(0, 0), a2, voffA);
            PG8_BAR; PG8_WAIT_L(0); PG8_MMA(1, 0, At, B0); PG8_BAR; PG8_SCHED;
            PG8_STAGE(PG8_SB(0, 1), b2 + hstep, voffB);
            PG8_WAIT_V(6); PG8_BAR; PG8_MMA(1, 1, At, B1); PG8_BAR;
            PG8_LDB(B0, 1, 0); PG8_SCHED; PG8_LDA(At, 1, 0); PG8_STAGE(PG8_SA(0, 1), a2 + hstep, voffA);
            PG8_WAIT_L(8); PG8_BAR; PG8_WAIT_L(0); PG8_MMA(0, 0, At, B0); PG8_BAR; PG8_SCHED;
            PG8_LDB(B1, 1, 1); PG8_STAGE(PG8_SB(1, 0), b3, voffB);
            PG8_BAR; PG8_WAIT_L(0); PG8_MMA(0, 1, At, B1); PG8_BAR;
            PG8_LDA(At, 1, 1); PG8_STAGE(PG8_SA(1, 0), a3, voffA);
            PG8_BAR; PG8_WAIT_L(0); PG8_MMA(1, 0, At, B0); PG8_BAR; PG8_SCHED;
            PG8_STAGE(PG8_SB(1, 1), b3 + hstep, voffB);
            PG8_WAIT_V(6); PG8_BAR; PG8_MMA(1, 1, At, B1); PG8_BAR;
            }
        }
        if constexpr (ALIGN_EPI) { if (wr == 0) PG8_BAR; }
        if constexpr (!Epi::AFTER_DRAIN) { E(acc, cur, wr, wc, fr, fq); S.done(cur); }
        if (!has_next) break;
#pragma unroll
        for (int a = 0; a < 2; ++a)
#pragma unroll
            for (int b = 0; b < 2; ++b)
#pragma unroll
                for (int m = 0; m < 4; ++m)
#pragma unroll
                    for (int n = 0; n < 2; ++n) acc[a][b][m][n] = (f32x4){0.f, 0.f, 0.f, 0.f};
        cur = nxt; cA = nA; cB = nB; ++ui;
        if constexpr (ALIGN_EPI) { if (wr == 1) PG8_BAR; }
    }
    PG8_WAIT_V(0);
    if constexpr (!ALIGN_EPI) { if (wr == 0) PG8_BAR; }
    PG8_BAR;
    if constexpr (Epi::AFTER_DRAIN) { E.fused(acc, cur, wr, wc, fr, fq, lds, wid, lane); S.done(cur); }
#undef PG8_SA
#undef PG8_SB
#undef PG8_STAGE
#undef PG8_LDA
#undef PG8_LDB
#undef PG8_MMA
#undef PG8_WAIT_V
#undef PG8_WAIT_L
#undef PG8_BAR
#undef PG8_SCHED
}
}
namespace att {
#define ATT_LAS __attribute__((address_space(3)))
typedef unsigned short bf16_t;
typedef short bf16x8 __attribute__((ext_vector_type(8)));
typedef short s16x4 __attribute__((ext_vector_type(4)));
typedef short v4i16_t __attribute__((ext_vector_type(4)));
typedef float f32x16 __attribute__((ext_vector_type(16)));
typedef float f32x4 __attribute__((ext_vector_type(4)));
typedef unsigned u32x4 __attribute__((ext_vector_type(4)));
typedef float f32x2_t __attribute__((ext_vector_type(2)));
typedef __bf16 bf16x2_t __attribute__((ext_vector_type(2)));
constexpr int SEQ = 4096, PITCH = 2048, QB = 256, KVB = 64, TILE_BYTES = 16384;
constexpr int LDS_K = 0, LDS_V = 2 * TILE_BYTES, LDS_WS = 4 * TILE_BYTES, LDS_FLAG = LDS_WS + 8 * 256, LDS_BYTES = LDS_FLAG + 64;
constexpr float SB_DONE = -160.0f;
__device__ __forceinline__ unsigned off_b(unsigned row, unsigned ch) { return 256u * row + 16u * (ch ^ (((row & 3u) << 2) | ((row >> 2) & 3u))); }
__device__ __forceinline__ unsigned cvtpk(float lo, float hi) { f32x2_t v = {lo, hi}; bf16x2_t b = __builtin_convertvector(v, bf16x2_t); return __builtin_bit_cast(unsigned, b); }
__device__ __forceinline__ s16x4 vtr(const ATT_LAS unsigned char* p) { return __builtin_bit_cast(s16x4, __builtin_amdgcn_ds_read_tr16_b64_v4i16((ATT_LAS v4i16_t*)p)); }
#define ATT_MFMA(a, b, c) __builtin_amdgcn_mfma_f32_32x32x16_bf16((a), (b), (c), 0, 0, 0)

template <int MODE>
__device__ __forceinline__ void attn_unit(ATT_LAS unsigned char* lds, const bf16_t* __restrict__ Qp, const bf16_t* __restrict__ Kp, const bf16_t* __restrict__ Vp, void* Op, int q0) {
  int tid_ = threadIdx.x; asm volatile("" : "+v"(tid_));
  const int tid = tid_, lane = tid & 63, r32 = lane & 31, hi = lane >> 5;
  const int wid = __builtin_amdgcn_readfirstlane(tid >> 6);
  const int qrow0 = q0 + 32 * wid, t = qrow0 + r32;
  const int NT = (q0 + QB) / KVB;
  bf16x8 qf[8];
#pragma unroll
  for (int s = 0; s < 8; ++s) qf[s] = *(const bf16x8*)(Qp + (size_t)t * PITCH + 16 * s + 8 * hi);
  const int srow = tid >> 4, sch = tid & 15;
  const unsigned soff = off_b((unsigned)srow, (unsigned)sch);
  const bf16_t* kg = Kp + (size_t)srow * PITCH + 8 * sch;
  const bf16_t* vg = Vp + (size_t)srow * PITCH + 8 * sch;
  unsigned koff[8];
  { const unsigned X = (((unsigned)r32 & 3u) << 2) | (((unsigned)r32 >> 2) & 3u);
#pragma unroll
    for (int s = 0; s < 8; ++s) koff[s] = 256u * (unsigned)r32 + 16u * (((unsigned)(2 * s + hi)) ^ X); }
  unsigned voff[4][2];
  { const unsigned q = ((unsigned)lane & 15u) >> 2, p = (unsigned)lane & 3u, blk = ((unsigned)lane >> 4) & 1u;
#pragma unroll
    for (int c = 0; c < 4; ++c)
#pragma unroll
      for (int jj = 0; jj < 2; ++jj) voff[c][jj] = off_b(8u * jj + 4u * hi + q, 4u * c + 2u * blk + (p >> 1)) + 8u * (p & 1u); }
  ATT_LAS float* wsf = (ATT_LAS float*)(lds + LDS_WS) + wid * 64;
  ATT_LAS unsigned* flags = (ATT_LAS unsigned*)(lds + LDS_FLAG);
  f32x16 o[4];
#pragma unroll
  for (int c = 0; c < 4; ++c)
#pragma unroll
    for (int r = 0; r < 16; ++r) o[c][r] = 0.f;
  float m_run = -INFINITY, l_run = 0.f, carry = 0.f;
  bool wdone = false;
  u32x4 sk0, sk1, sv0, sv1;
  { const int jt = MODE == 0 ? NT - 1 : 0; const size_t go = (size_t)(KVB * jt) * PITCH;
    sk0 = *(const u32x4*)(kg + go); sk1 = *(const u32x4*)(kg + go + 32 * PITCH); sv0 = *(const u32x4*)(vg + go); sv1 = *(const u32x4*)(vg + go + 32 * PITCH); }
  *(ATT_LAS u32x4*)(lds + LDS_K + soff) = sk0; *(ATT_LAS u32x4*)(lds + LDS_K + soff + 8192) = sk1;
  *(ATT_LAS u32x4*)(lds + LDS_V + soff) = sv0; *(ATT_LAS u32x4*)(lds + LDS_V + soff + 8192) = sv1;
  __syncthreads();
  for (int i = 0; i < NT; ++i) {
    const int jt = MODE == 0 ? NT - 1 - i : i; const int buf = i & 1; const int kv0 = KVB * jt;
    const bool more = i + 1 < NT;
    if (more) { const int jn = MODE == 0 ? jt - 1 : jt + 1; const size_t go = (size_t)(KVB * jn) * PITCH;
      sk0 = *(const u32x4*)(kg + go); sk1 = *(const u32x4*)(kg + go + 32 * PITCH); sv0 = *(const u32x4*)(vg + go); sv1 = *(const u32x4*)(vg + go + 32 * PITCH); }
    const bool active = MODE == 0 ? (kv0 < qrow0 + 31 && !wdone) : (kv0 <= qrow0 + 31);
    if (active) {
      const ATT_LAS unsigned char* kb = lds + LDS_K + buf * TILE_BYTES;
      const ATT_LAS unsigned char* vb = lds + LDS_V + buf * TILE_BYTES;
      f32x16 p0, p1;
#pragma unroll
      for (int r = 0; r < 16; ++r) { p0[r] = 0.f; p1[r] = 0.f; }
#pragma unroll
      for (int s = 0; s < 8; ++s) {
        const bf16x8 k0 = *(const ATT_LAS bf16x8*)(kb + koff[s]);
        const bf16x8 k1 = *(const ATT_LAS bf16x8*)(kb + koff[s] + 8192);
        p0 = ATT_MFMA(k0, qf[s], p0); p1 = ATT_MFMA(k1, qf[s], p1);
      }
      if (MODE == 1) {
        const bool full = (kv0 + 63 <= qrow0);
        if (!full) {
#pragma unroll
          for (int r = 0; r < 16; ++r) { const int kv = kv0 + (r & 3) + 8 * (r >> 2) + 4 * hi; if (kv > t) p0[r] = -INFINITY; if (kv + 32 > t) p1[r] = -INFINITY; }
        }
        float mx = fmaxf(p0[0], p1[0]);
#pragma unroll
        for (int r = 1; r < 16; ++r) mx = fmaxf(mx, fmaxf(p0[r], p1[r]));
        mx = fmaxf(mx, __shfl_xor(mx, 32));
        const float m_new = fmaxf(m_run, mx);
        const float alpha = __builtin_amdgcn_exp2f(m_run - m_new);
        m_run = m_new;
        float rs = 0.f;
#pragma unroll
        for (int r = 0; r < 16; ++r) { p0[r] = __builtin_amdgcn_exp2f(p0[r] - m_new); p1[r] = __builtin_amdgcn_exp2f(p1[r] - m_new); rs += p0[r] + p1[r]; }
        l_run = l_run * alpha + rs;
        if (__builtin_amdgcn_ballot_w64(alpha != 1.0f) != 0ull) {
          if (hi == 0) wsf[r32] = alpha;
#pragma unroll
          for (int g = 0; g < 4; ++g) { const f32x4 a4 = *(const ATT_LAS f32x4*)(wsf + 8 * g + 4 * hi);
#pragma unroll
            for (int c = 0; c < 4; ++c)
#pragma unroll
              for (int e = 0; e < 4; ++e) o[c][4 * g + e] *= a4[e]; }
        }
      } else {
        const bool full = (kv0 + 63 < qrow0);
        float l1a[16], l1b[16];
#pragma unroll
        for (int r = 0; r < 16; ++r) {
          const int kv = kv0 + (r & 3) + 8 * (r >> 2) + 4 * hi;
          { const float z = p0[r]; const float e = __builtin_amdgcn_exp2f(-fabsf(z)); const float lg = __builtin_amdgcn_logf(1.0f + e);
            float v = -(fmaxf(z, 0.f) + lg); if (!full && !(kv < t)) v = 0.f; l1a[r] = v; }
          { const float z = p1[r]; const float e = __builtin_amdgcn_exp2f(-fabsf(z)); const float lg = __builtin_amdgcn_logf(1.0f + e);
            float v = -(fmaxf(z, 0.f) + lg); if (!full && !(kv + 32 < t)) v = 0.f; l1b[r] = v; }
        }
        float SM[9], SP[9]; SM[8] = 0.f; SP[8] = 0.f;
#pragma unroll
        for (int g = 3; g >= 0; --g) SM[4 + g] = ((l1b[4 * g] + l1b[4 * g + 1]) + (l1b[4 * g + 2] + l1b[4 * g + 3])) + SM[5 + g];
#pragma unroll
        for (int g = 3; g >= 0; --g) SM[g] = ((l1a[4 * g] + l1a[4 * g + 1]) + (l1a[4 * g + 2] + l1a[4 * g + 3])) + SM[1 + g];
#pragma unroll
        for (int i2 = 0; i2 < 8; ++i2) SP[i2] = __shfl_xor(SM[i2], 32);
#pragma unroll
        for (int i2 = 0; i2 < 8; ++i2) {
          float later = carry + SM[i2 + 1] + (hi ? SP[i2 + 1] : SP[i2]);
#pragma unroll
          for (int e = 3; e >= 0; --e) {
            const int r = 4 * (i2 & 3) + e; const int kv = kv0 + 32 * (i2 >> 2) + e + 8 * (i2 & 3) + 4 * hi;
            const float z = (i2 >> 2) ? p1[r] : p0[r]; const float l1 = (i2 >> 2) ? l1b[r] : l1a[r];
            float a = __builtin_amdgcn_exp2f(z + l1 + later); if (!full && !(kv < t)) a = 0.f;
            if (i2 >> 2) p1[r] = a; else p0[r] = a;
            later += l1;
          }
        }
        carry += SM[0] + SP[0];
        wdone = (__builtin_amdgcn_ballot_w64(carry >= SB_DONE) == 0ull);
      }
#pragma unroll
      for (int s4 = 0; s4 < 4; ++s4) {
        u32x4 pw;
        if (s4 >> 1) { const int b8 = 8 * (s4 & 1); pw[0] = cvtpk(p1[b8], p1[b8 + 1]); pw[1] = cvtpk(p1[b8 + 2], p1[b8 + 3]); pw[2] = cvtpk(p1[b8 + 4], p1[b8 + 5]); pw[3] = cvtpk(p1[b8 + 6], p1[b8 + 7]); }
        else { const int b8 = 8 * (s4 & 1); pw[0] = cvtpk(p0[b8], p0[b8 + 1]); pw[1] = cvtpk(p0[b8 + 2], p0[b8 + 3]); pw[2] = cvtpk(p0[b8 + 4], p0[b8 + 5]); pw[3] = cvtpk(p0[b8 + 6], p0[b8 + 7]); }
        const bf16x8 pa = __builtin_bit_cast(bf16x8, pw);
#pragma unroll
        for (int c = 0; c < 4; ++c) {
          const s16x4 lo = vtr(vb + voff[c][0] + 4096 * s4), hh = vtr(vb + voff[c][1] + 4096 * s4);
          const bf16x8 vf = __builtin_shufflevector(lo, hh, 0, 1, 2, 3, 4, 5, 6, 7);
          o[c] = ATT_MFMA(pa, vf, o[c]);
        }
      }
    }
    if (more) {
      const unsigned nb = (unsigned)((buf ^ 1) * TILE_BYTES);
      *(ATT_LAS u32x4*)(lds + LDS_K + nb + soff) = sk0; *(ATT_LAS u32x4*)(lds + LDS_K + nb + soff + 8192) = sk1;
      *(ATT_LAS u32x4*)(lds + LDS_V + nb + soff) = sv0; *(ATT_LAS u32x4*)(lds + LDS_V + nb + soff + 8192) = sv1;
    }
    if (MODE == 0) { if (lane == 0) flags[(i & 1) * 8 + wid] = wdone ? 1u : 0u; }
    __syncthreads();
    if (MODE == 0) {
      const u32x4 fa = *(const ATT_LAS u32x4*)(flags + (i & 1) * 8), fb = *(const ATT_LAS u32x4*)(flags + (i & 1) * 8 + 4);
      const unsigned all = fa[0] & fa[1] & fa[2] & fa[3] & fb[0] & fb[1] & fb[2] & fb[3];
      if (__builtin_amdgcn_readfirstlane(all) != 0u) break;
    }
  }
  if (MODE == 1) {
    const float l = l_run + __shfl_xor(l_run, 32);
    if (hi == 0) wsf[r32] = 1.0f / l;
    float* O = (float*)Op;
#pragma unroll
    for (int g = 0; g < 4; ++g) { const f32x4 i4 = *(const ATT_LAS f32x4*)(wsf + 8 * g + 4 * hi);
#pragma unroll
      for (int e = 0; e < 4; ++e) { float* orow = O + (size_t)(qrow0 + 8 * g + 4 * hi + e) * PITCH + r32;
#pragma unroll
        for (int c = 0; c < 4; ++c) orow[32 * c] = o[c][4 * g + e] * i4[e]; } }
  } else {
    bf16_t* O = (bf16_t*)Op;
#pragma unroll
    for (int g = 0; g < 4; ++g)
#pragma unroll
      for (int e = 0; e < 4; ++e) { bf16_t* orow = O + (size_t)(qrow0 + 8 * g + 4 * hi + e) * PITCH + r32;
#pragma unroll
        for (int c = 0; c < 4; ++c) orow[32 * c] = (bf16_t)(cvtpk(o[c][4 * g + e], 0.f) & 0xffffu); }
  }
}
#undef ATT_MFMA
}
#define GAS __attribute__((address_space(1)))
#define LAS __attribute__((address_space(3)))
typedef unsigned short bf16;
typedef unsigned v4u __attribute__((ext_vector_type(4)));
typedef float f32x4 __attribute__((ext_vector_type(4)));
typedef short bf16x8 __attribute__((ext_vector_type(8)));
typedef GAS unsigned gu32;
typedef GAS unsigned long long gu64;
#define RLX_AGENT __ATOMIC_RELAXED, __HIP_MEMORY_SCOPE_AGENT
#define LDS_WAIT() asm volatile("s_waitcnt lgkmcnt(0)" ::: "memory")
#define VM_WAIT() asm volatile("s_waitcnt vmcnt(0)" ::: "memory")
__device__ __forceinline__ unsigned long long rt() { return __builtin_amdgcn_s_memrealtime(); }
__device__ __forceinline__ unsigned f2bf(float f) { unsigned u = __builtin_bit_cast(unsigned, f); return (u + 0x7fffu + ((u >> 16) & 1u)) >> 16; }
__device__ __forceinline__ unsigned pk2(float lo, float hi) { return f2bf(lo) | (f2bf(hi) << 16); }

#define XB_TMO      128
#define XB_XCNT(j)  (256  + 64 * (j))
#define XB_XSUB(j)  (1280 + 64 * (j))
#define XB_XGEN(j)  (2304 + 64 * (j))
#define XB_TOP      3328
#define XB_TOPGEN   3392
#define XCD_BAR_WORDS 3456
#define XB_SPIN_CAP (1u << 18)

__device__ __forceinline__ unsigned xb_ld(unsigned* p)              { return __hip_atomic_load(p, __ATOMIC_RELAXED, __HIP_MEMORY_SCOPE_AGENT); }
__device__ __forceinline__ unsigned xb_add(unsigned* p, unsigned v) { return __hip_atomic_fetch_add(p, v, __ATOMIC_RELAXED, __HIP_MEMORY_SCOPE_AGENT); }
__device__ __forceinline__ unsigned xb_xcc_id() { return (unsigned)__builtin_amdgcn_s_getreg((3 << 11) | 20) & 0xFu; }
#define XB_SPIN(cond, bar) do { unsigned _sp = 0; while (cond) { __builtin_amdgcn_s_sleep(1); \
    if ((++_sp & 255u) == 0u) { if (xb_ld(&(bar)[XB_TMO])) break; if (_sp > XB_SPIN_CAP) { atomicAdd(&(bar)[XB_TMO], 1u); break; } } } } while (0)

struct XcdBarrier {
    unsigned* bar; unsigned x;
    volatile LAS unsigned* st;
};

__device__ __forceinline__ XcdBarrier xcd_barrier_post(unsigned* bar, volatile LAS unsigned* st) {
    XcdBarrier b; b.bar = bar; b.x = xb_xcc_id(); b.st = st;
    if (threadIdx.x == 0) (void)xb_add(&bar[XB_XCNT(b.x)], 1u);
    return b;
}
__device__ __forceinline__ void xcd_barrier_complete(unsigned* bar, unsigned x, unsigned& nloc, unsigned& nx) {
    const unsigned G = gridDim.x * gridDim.y * gridDim.z;
    unsigned sum, cnt, mine, sp = 0u;
    for (;;) {
        sum = 0u; cnt = 0u; mine = 0u;
#pragma unroll
        for (unsigned j = 0; j < 16; ++j) { const unsigned c = xb_ld(&bar[XB_XCNT(j)]); sum += c; cnt += (c > 0u) ? 1u : 0u; mine = (j == x) ? c : mine; }
        if (sum == G) break;
        __builtin_amdgcn_s_sleep(1);
        if ((++sp & 255u) == 0u) { if (xb_ld(&bar[XB_TMO])) break; if (sp > XB_SPIN_CAP) { atomicAdd(&bar[XB_TMO], 1u); break; } }
    }
    nloc = mine > 0u ? mine : 1u; nx = cnt > 0u ? cnt : 1u;
}

__device__ __forceinline__ void xcd_barrier(const XcdBarrier& b) {
    asm volatile("s_waitcnt vmcnt(0)" ::: "memory");
    __syncthreads();
    if (threadIdx.x == 0) {
        unsigned* bar = b.bar;
        __builtin_amdgcn_s_waitcnt(0);
        unsigned nloc = b.st[0], nx = b.st[1];
        if (nloc == 0u) { xcd_barrier_complete(bar, b.x, nloc, nx); b.st[0] = nloc; b.st[1] = nx; }
        const unsigned old = xb_add(&bar[XB_XSUB(b.x)], 1u);
        const unsigned gen = old / nloc;
        if (old + 1u == (gen + 1u) * nloc) {
            __builtin_amdgcn_fence(__ATOMIC_RELEASE, "agent");
            asm volatile("s_waitcnt vmcnt(0)" ::: "memory");
            const unsigned og = xb_add(&bar[XB_TOP], 1u);
            const unsigned tg = og / nx;
            if (og + 1u == (tg + 1u) * nx) xb_add(&bar[XB_TOPGEN], 1u);
            else XB_SPIN(xb_ld(&bar[XB_TOPGEN]) == tg, bar);
            __builtin_amdgcn_fence(__ATOMIC_ACQUIRE, "agent");
            xb_add(&bar[XB_XGEN(b.x)], 1u);
            asm volatile("s_waitcnt vmcnt(0)" ::: "memory");
        } else {
            XB_SPIN(xb_ld(&bar[XB_XGEN(b.x)]) == gen, bar);
            __builtin_amdgcn_fence(__ATOMIC_ACQUIRE, "agent");
            asm volatile("s_waitcnt vmcnt(0)" ::: "memory");
        }
    }
    __syncthreads();
}
constexpr int NWAVES = 8;
constexpr int BATCH = 2, SEQ = 4096, D = 2048, M = BATCH * SEQ, FF = 5632, NPROJ = 6144;
constexpr float EPS = 1e-6f;
constexpr float C2 = 0.08838834764831845f * 1.4426950408889634f;
constexpr float LAMBDA_INIT = 0.35550906759f;
constexpr size_t MiB = 1u << 20;
constexpr size_t WS_CTL = 0, CTL_ZERO_BYTES = 32768;
constexpr size_t WS_ROPE = 1 * MiB;
constexpr size_t WS_WKVQ = 4 * MiB, WS_WO_B = 28 * MiB, WS_WGU_B = 36 * MiB, WS_WD_B = 80 * MiB;
constexpr size_t WS_AB = 102 * MiB;
constexpr size_t WS_P0 = 134 * MiB, WS_P1 = 166 * MiB, WS_P2 = 198 * MiB;
constexpr size_t WS_ACT = 230 * MiB;
constexpr size_t WS_WQKV_A = 318 * MiB, WS_WO_A = 342 * MiB, WS_WGU_A = 350 * MiB, WS_WD_A = 394 * MiB;
constexpr size_t WS_OB = 318 * MiB;
constexpr size_t WS_END = 446 * MiB;
constexpr int CW_BAR = 1024;
constexpr int RING_BYTES = 131072, LDSCTL_OFF = RING_BYTES, MISC_OFF = LDSCTL_OFF + 320, LDS_BYTES = 147456;
static_assert(att::LDS_BYTES <= RING_BYTES, "attention LDS");

__device__ __forceinline__ float wave_sum(float v) {
#pragma unroll
    for (int o = 1; o < 64; o <<= 1) v += __shfl_xor(v, o);
    return v;
}
__device__ __forceinline__ void transpose_item(const float* __restrict__ W, int K, int N, bf16* WT, int row_off, int gu_map, const float* __restrict__ gain, LAS float* scr, int item, int lane) {
    const int nblk = N / 32, kb = item / nblk, nb = item - kb * nblk, k0 = 64 * kb, n0 = 32 * nb;
#pragma unroll 8
    for (int i = 0; i < 32; ++i) { const int kk = 2 * i + (lane >> 5); float w = W[(size_t)(k0 + kk) * N + n0 + (lane & 31)]; if (gain) w *= gain[k0 + kk]; scr[kk * 33 + (lane & 31)] = w; }
    LDS_WAIT(); asm volatile("" ::: "memory");
    int drow0 = row_off + n0;
    if (gu_map) { const int half = N / 2, isup = n0 >= half ? 1 : 0, j = n0 - isup * half; drow0 = 256 * (j >> 7) + 128 * isup + (j & 127); }
    const int c = lane & 7;
#pragma unroll
    for (int j = 0; j < 4; ++j) { const int n = (lane >> 3) + 8 * j; const LAS float* s = scr + (8 * c) * 33 + n;
        v4u o; o.x = pk2(s[0 * 33], s[1 * 33]); o.y = pk2(s[2 * 33], s[3 * 33]); o.z = pk2(s[4 * 33], s[5 * 33]); o.w = pk2(s[6 * 33], s[7 * 33]);
        *(GAS v4u*)(WT + (size_t)(drow0 + n) * K + k0 + 8 * c) = o; }
    LDS_WAIT(); asm volatile("" ::: "memory");
}
__device__ __forceinline__ void rms_rows(const float* X, bf16* out, int gw, int NGW, int lane) {
    for (int m = gw; m < M; m += NGW) {
        const GAS f32x4* xr = (const GAS f32x4*)(X + (size_t)m * D) + lane;
        f32x4 v[8]; float s = 0.f;
#pragma unroll
        for (int j = 0; j < 8; ++j) { v[j] = xr[64 * j]; s += (v[j].x * v[j].x + v[j].y * v[j].y) + (v[j].z * v[j].z + v[j].w * v[j].w); }
        const float r = 1.0f / sqrtf(wave_sum(s) * (1.0f / D) + EPS);
        GAS unsigned long long* o8 = (GAS unsigned long long*)(out + (size_t)m * D) + lane;
#pragma unroll
        for (int j = 0; j < 8; ++j) o8[64 * j] = (unsigned long long)pk2(v[j].x * r, v[j].y * r) | ((unsigned long long)pk2(v[j].z * r, v[j].w * r) << 32);
    }
}
__device__ __forceinline__ float bf2f(unsigned short h) { return __uint_as_float(((unsigned)h) << 16); }
__device__ __forceinline__ void qknorm_rope_row(bf16* row, const float* __restrict__ gain, float sc, const float* __restrict__ cs  , int lane) {
    const int cc = lane & 7;
    float ga[8], gb[8], co[8], si[8];
#pragma unroll
    for (int e = 0; e < 8; ++e) { ga[e] = gain[8 * cc + e]; gb[e] = gain[64 + 8 * cc + e]; co[e] = cs[2 * (8 * cc + e)]; si[e] = cs[2 * (8 * cc + e) + 1]; }
#pragma unroll
    for (int it = 0; it < 2; ++it) {
        bf16* p = row + 128 * (8 * it + (lane >> 3)) + 8 * cc;
        const v4u a = *(const GAS v4u*)p, b = *(const GAS v4u*)(p + 64);
        float xa[8], xb[8]; float ss = 0.f;
#pragma unroll
        for (int e = 0; e < 4; ++e) { xa[2 * e] = __uint_as_float(a[e] << 16); xa[2 * e + 1] = __uint_as_float(a[e] & 0xffff0000u); xb[2 * e] = __uint_as_float(b[e] << 16); xb[2 * e + 1] = __uint_as_float(b[e] & 0xffff0000u); }
#pragma unroll
        for (int e = 0; e < 8; ++e) ss += xa[e] * xa[e] + xb[e] * xb[e];
        ss += __shfl_xor(ss, 1); ss += __shfl_xor(ss, 2); ss += __shfl_xor(ss, 4);
        const float r = 1.0f / sqrtf(ss * (1.0f / 128.0f) + EPS);
        float oa[8], ob[8];
#pragma unroll
        for (int e = 0; e < 8; ++e) { const float ya = xa[e] * r * ga[e], yb = xb[e] * r * gb[e]; oa[e] = (ya * co[e] - yb * si[e]) * sc; ob[e] = (yb * co[e] + ya * si[e]) * sc; }
        v4u wa, wb;
#pragma unroll
        for (int e = 0; e < 4; ++e) { wa[e] = pk2(oa[2 * e], oa[2 * e + 1]); wb[e] = pk2(ob[2 * e], ob[2 * e + 1]); }
        *(GAS v4u*)p = wa; *(GAS v4u*)(p + 64) = wb;
    }
}

struct Args { const float* in[22]; float* out; unsigned char* ws; };
typedef __attribute__((address_space(4))) const Args* ArgsCP;
__device__ __forceinline__ ArgsCP argp() { ArgsCP p = (ArgsCP)__builtin_amdgcn_kernarg_segment_ptr(); asm volatile("" : "+s"(p)); return p; }


#ifndef MK_CG_ALL
#define MK_CG_ALL 0
#endif
#if MK_CG_ALL
#define GSYNC() cg::this_grid().sync()
#else
#define GSYNC() xcd_barrier(bar)
#endif
__device__ __forceinline__ int opaque_tid() { int t = threadIdx.x; asm volatile("" : "+v"(t)); return t; }
template <int L>
__device__ __forceinline__ void layer_body(LAS unsigned char* lds, unsigned char* ws, const float* x, float* out, const XcdBarrier& bar,
                                           int G, int bx, int vcu, int gw, int NGW, int lane) {
    bf16* AB = (bf16*)(ws + WS_AB); bf16* P0 = (bf16*)(ws + WS_P0); bf16* P1 = (bf16*)(ws + WS_P1); bf16* P2 = (bf16*)(ws + WS_P2);
    bf16* ACT = (bf16*)(ws + WS_ACT); float* OB = (float*)(ws + WS_OB); float* ROPE = (float*)(ws + WS_ROPE);
        if (L == 1) { rms_rows(out, AB, gw, NGW, lane); GSYNC(); }
        {
            pg8::Gemm g{AB, (const bf16*)(ws + (L == 0 ? WS_WQKV_A : WS_WKVQ)), M, NPROJ, D}; pg8::StaticOrder S; S.init(M, NPROJ, G, bx);
            pg8::EpiBf16<0> E{P0, D, nullptr, D, (size_t)(WS_P1 - WS_P0) / 2, L == 0 ? C2 : 1.0f};
            pg8::gemm_phase<pg8::EpiBf16<0>, pg8::StaticOrder, true, true>(lds, g, S, E);
        }
        GSYNC();
        if constexpr (L == 0) {
            constexpr int TOTAL = 32 * 16; const int per = (TOTAL + G - 1) / G;
            for (int idx = vcu * per; idx < (vcu + 1) * per && idx < TOTAL; ++idx) {
                const int hp = idx >> 4, k = idx & 15, qb = (k & 1) ? 15 - (k >> 1) : (k >> 1);
                const size_t base = (size_t)(hp >> 4) * SEQ * D + 128 * (hp & 15);
                att::attn_unit<0>(lds, P0 + base, P1 + base, P2 + base, (void*)(AB + base), qb * att::QB);
            }
            GSYNC();
        } else {
            for (int item = gw; item < 2 * M; item += NGW) {
                const int m = item >> 1, isq = item & 1;
                qknorm_rope_row((isq ? P2 : P0) + (size_t)m * D, isq ? argp()->in[12] : argp()->in[9], isq ? C2 : 1.0f, ROPE + (size_t)(m & (SEQ - 1)) * 128, lane);
            }
            GSYNC();
            constexpr int TOTAL = 64 * 16; const int per = (TOTAL + G - 1) / G;
            for (int idx = vcu * per; idx < (vcu + 1) * per && idx < TOTAL; ++idx) {
                const int hp = idx >> 4, k = idx & 15, qb = (k & 1) ? 15 - (k >> 1) : (k >> 1);
                const int j = hp & 1, c = (hp >> 1) & 1, h = (hp >> 2) & 7, b = hp >> 5;
                const size_t rb = (size_t)b * SEQ * D;
                att::attn_unit<1>(lds, P2 + rb + (2 * h + c) * 128, P0 + rb + (2 * h + c) * 128, P1 + rb + 256 * h + 128 * j, (void*)(OB + (size_t)c * M * D + rb + 256 * h + 128 * j), qb * att::QB);
            }
            GSYNC();
            {
                const float a1 = argp()->in[13][lane] * argp()->in[14][lane] + argp()->in[13][lane + 64] * argp()->in[14][lane + 64];
                const float a2 = argp()->in[15][lane] * argp()->in[16][lane] + argp()->in[15][lane + 64] * argp()->in[16][lane + 64];
                const float lam = expf(wave_sum(a1)) - expf(wave_sum(a2)) + LAMBDA_INIT;
                const f32x4 gs = *(const GAS f32x4*)(argp()->in[17] + 4 * lane);
                for (int m = gw; m < M; m += NGW) {
#pragma unroll
                    for (int h = 0; h < 8; ++h) {
                        const size_t off = (size_t)m * D + 256 * h + 4 * lane;
                        const f32x4 o0 = *(const GAS f32x4*)(OB + off), o1 = *(const GAS f32x4*)(OB + (size_t)M * D + off);
                        const f32x4 o = o0 - lam * o1;
                        const float ss = wave_sum((o.x * o.x + o.y * o.y) + (o.z * o.z + o.w * o.w));
                        const float r = (1.0f - LAMBDA_INIT) / sqrtf(ss * (1.0f / 256.0f) + EPS);
                        *(GAS unsigned long long*)(AB + off) = (unsigned long long)pk2(o.x * r * gs.x, o.y * r * gs.y) | ((unsigned long long)pk2(o.z * r * gs.z, o.w * r * gs.w) << 32);
                    }
                }
            }
            GSYNC();
        }
        {
            pg8::Gemm g{AB, (const bf16*)(ws + (L == 0 ? WS_WO_A : WS_WO_B)), M, D, D}; pg8::StaticOrder S; S.init(M, D, G, bx);
            pg8::EpiRes E{L == 0 ? x : (const float*)out, out, D};
            pg8::gemm_phase<pg8::EpiRes, pg8::StaticOrder, true, true>(lds, g, S, E);
        }
        GSYNC();
        rms_rows(out, AB, gw, NGW, lane);
        GSYNC();
        {
            pg8::Gemm g{AB, (const bf16*)(ws + (L == 0 ? WS_WGU_A : WS_WGU_B)), M, 2 * FF, D}; pg8::StaticOrder S; S.init(M, 2 * FF, G, bx);
            pg8::EpiSwiglu E{ACT, FF};
            pg8::gemm_phase<pg8::EpiSwiglu, pg8::StaticOrder, true, true>(lds, g, S, E);
        }
        GSYNC();
        {
            pg8::Gemm g{ACT, (const bf16*)(ws + (L == 0 ? WS_WD_A : WS_WD_B)), M, D, FF}; pg8::StaticOrder S; S.init(M, D, G, bx);
            pg8::EpiRes E{(const float*)out, out, D};
            pg8::gemm_phase<pg8::EpiRes, pg8::StaticOrder, true, true>(lds, g, S, E);
        }
        if (L == 0) GSYNC();
}

__global__ void __launch_bounds__(NWAVES * 64, 2) fwd_megakernel(Args args) {
    extern __shared__ __attribute__((aligned(16))) unsigned char lds_raw[];
    LAS unsigned char* lds = (LAS unsigned char*)lds_raw;
    volatile LAS unsigned* MISC = (volatile LAS unsigned*)(lds + MISC_OFF);
    const int tid = threadIdx.x, lane = tid & 63, wave = __builtin_amdgcn_readfirstlane(tid >> 6);
    const int G = gridDim.x; const int bx = blockIdx.x;
    const int vcu = (G % 8 == 0) ? (bx % 8) * (G / 8) + bx / 8 : bx;
    const int gw = vcu * NWAVES + wave, NGW = G * NWAVES;
    unsigned char* ws = argp()->ws;
    gu32* ctl = (gu32*)(ws + WS_CTL);
    const float* x = argp()->in[0]; float* out = argp()->out;
    bf16* AB = (bf16*)(ws + WS_AB); bf16* P0 = (bf16*)(ws + WS_P0); bf16* P1 = (bf16*)(ws + WS_P1); bf16* P2 = (bf16*)(ws + WS_P2);
    bf16* ACT = (bf16*)(ws + WS_ACT); float* OB = (float*)(ws + WS_OB); float* ROPE = (float*)(ws + WS_ROPE);
    for (int u = tid; u < (LDS_BYTES - LDSCTL_OFF) / 4; u += NWAVES * 64) ((LAS unsigned*)(lds + LDSCTL_OFF))[u] = 0u;
    __syncthreads();
    XcdBarrier bar = xcd_barrier_post((unsigned*)(ctl + CW_BAR), MISC + 8);


    {
        LAS float* scr = (LAS float*)(lds + wave * 16384);
        constexpr int I_QKV = 32 * 192, I_O = 32 * 64, I_GU = 32 * 352, I_D = 88 * 64, I_KV = 32 * 128;
        constexpr int NITEMS = I_QKV + 3 * I_O + 2 * I_GU + 2 * I_D + I_KV;
        for (int it = gw; it < NITEMS; it += NGW) {
            int r = it;
            if (r < I_QKV) { transpose_item(argp()->in[2], D, NPROJ, (bf16*)(ws + WS_WQKV_A), 0, 0, argp()->in[1], scr, r, lane); continue; } r -= I_QKV;
            if (r < I_O)   { transpose_item(argp()->in[3], D, D, (bf16*)(ws + WS_WO_A), 0, 0, nullptr, scr, r, lane); continue; } r -= I_O;
            if (r < I_GU)  { transpose_item(argp()->in[5], D, 2 * FF, (bf16*)(ws + WS_WGU_A), 0, 1, argp()->in[4], scr, r, lane); continue; } r -= I_GU;
            if (r < I_D)   { transpose_item(argp()->in[6], FF, D, (bf16*)(ws + WS_WD_A), 0, 0, nullptr, scr, r, lane); continue; } r -= I_D;
            if (r < I_KV)  { transpose_item(argp()->in[8], D, 2 * D, (bf16*)(ws + WS_WKVQ), 0, 0, argp()->in[7], scr, r, lane); continue; } r -= I_KV;
            if (r < I_O)   { transpose_item(argp()->in[11], D, D, (bf16*)(ws + WS_WKVQ), 2 * D, 0, argp()->in[10], scr, r, lane); continue; } r -= I_O;
            if (r < I_O)   { transpose_item(argp()->in[18], D, D, (bf16*)(ws + WS_WO_B), 0, 0, nullptr, scr, r, lane); continue; } r -= I_O;
            if (r < I_GU)  { transpose_item(argp()->in[20], D, 2 * FF, (bf16*)(ws + WS_WGU_B), 0, 1, argp()->in[19], scr, r, lane); continue; } r -= I_GU;
            transpose_item(argp()->in[21], FF, D, (bf16*)(ws + WS_WD_B), 0, 0, nullptr, scr, r, lane);
        }
        rms_rows(x, AB, gw, NGW, lane);
        for (int e = (vcu * NWAVES * 64 + tid); e < SEQ * 64; e += G * NWAVES * 64) {
            const int pos = e >> 6, i = e & 63;
            const float inv_freq = powf(10000.0f, -(float)i * (1.0f / 64.0f));
            const float ang = (float)pos * inv_freq;
            ROPE[2 * e] = cosf(ang); ROPE[2 * e + 1] = sinf(ang);
        }
    }
    cg::this_grid().sync();

    layer_body<0>(lds, ws, x, out, bar, G, bx, vcu, gw, NGW, lane);
    layer_body<1>(lds, ws, x, out, bar, G, bx, vcu, gw, NGW, lane);
}

extern "C" void kernel_launch(void* const* d_in, const int* in_sizes, int n_in, void* d_out, int out_size, void* d_ws, size_t ws_size, hipStream_t stream) {
    static int grid = 0;
    if (grid == 0) {
        if (n_in != 22 || in_sizes[0] != M * D || out_size != M * D || ws_size < WS_END) { fprintf(stderr, "kernel_launch: unexpected problem shape / workspace (n_in %d, in0 %d, out %d, ws %zu)\n", n_in, n_in > 0 ? in_sizes[0] : -1, out_size, ws_size); grid = -1; return; }
        int dev = 0, cus = 0, per_cu = 0;
        if (hipGetDevice(&dev) != hipSuccess || hipDeviceGetAttribute(&cus, hipDeviceAttributeMultiprocessorCount, dev) != hipSuccess) { grid = -1; return; }
        if (hipFuncSetAttribute((const void*)fwd_megakernel, hipFuncAttributeMaxDynamicSharedMemorySize, LDS_BYTES) != hipSuccess) { fprintf(stderr, "kernel_launch: hipFuncSetAttribute failed\n"); grid = -1; return; }
        if (hipOccupancyMaxActiveBlocksPerMultiprocessor(&per_cu, (const void*)fwd_megakernel, NWAVES * 64, LDS_BYTES) != hipSuccess || per_cu < 1) { fprintf(stderr, "kernel_launch: occupancy query says %d blocks per CU\n", per_cu); (void)hipGetLastError(); per_cu = 1; }
        grid = cus;
    }
    if (grid < 0) return;
    if (hipMemsetAsync((char*)d_ws + WS_CTL, 0, CTL_ZERO_BYTES, stream) != hipSuccess) { fprintf(stderr, "kernel_launch: memset failed\n"); return; }
    Args a{};
    for (int i = 0; i < 22; ++i) a.in[i] = (const float*)d_in[i];
    a.out = (float*)d_out; a.ws = (unsigned char*)d_ws;
    void* kargs[] = {&a};
    const hipError_t e = hipLaunchCooperativeKernel((const void*)fwd_megakernel, dim3(grid), dim3(NWAVES * 64), kargs, LDS_BYTES, stream);
    if (e != hipSuccess) fprintf(stderr, "kernel_launch: cooperative launch failed: %s (grid %d)\n", hipGetErrorString(e), grid);
}
```

```cpp
#include <hip/hip_runtime.h>
#include <hip/hip_cooperative_groups.h>
#include <cstdio>
#include <cstdint>
#include <cmath>
namespace cg = cooperative_groups;
namespace pg8 {
#define PG8_LAS __attribute__((address_space(3)))
typedef unsigned short bf16_t;
typedef short bf16x8 __attribute__((ext_vector_type(8)));
typedef float f32x4 __attribute__((ext_vector_type(4)));
typedef unsigned u32x4 __attribute__((ext_vector_type(4)));
constexpr int BM = 256, BK = 64, HALF = 128, HTB = HALF * BK * 2  , STAGE_BYTES = 8 * HTB, NXCD = 8, WGM = 8;

__host__ __device__ __forceinline__ int lds_byte(int r, int c) { const int st = (r >> 4) * 2 + (c >> 5), rr = r & 15, cc = c & 31, ob = rr * 64 + cc * 2; return st * 1024 + (ob ^ (((ob >> 9) & 1) << 5)); }
__host__ __device__ __forceinline__ void stage_rc(int b, int& R, int& C) { const int st = b / 1024, sb = b % 1024, swz = sb ^ (((sb >> 9) & 1) << 5); R = (st >> 1) * 16 + swz / 64; C = (st & 1) * 32 + (swz % 64) / 2; }
__host__ __device__ __forceinline__ int perm32(int rho) { const int n = rho >> 4, i = rho & 15; return 8 * (i >> 2) + 4 * n + (i & 3); }

struct Unit { int pm, pn; };
struct Gemm { const bf16_t* A; const bf16_t* Bt; int M, N, K; };

struct StaticOrder {
    int nM, nN, nwg, G, c;
    __host__ __device__ void init(int M, int N, int G_, int c_) { nM = M / BM; nN = N / BM; nwg = nM * nN; G = G_; c = c_; }
    __host__ __device__ bool next(int i, Unit& u) const {
        const long L = (long)i * G + c; if (L >= nwg) return false;
        int wgid = (int)L; { const int q = nwg / NXCD, r = nwg % NXCD, xcd = wgid % NXCD, off = wgid / NXCD; wgid = (xcd < r ? xcd * (q + 1) : r * (q + 1) + (xcd - r) * q) + off; }
        const int nig = WGM * nN, gid = wgid / nig, fm = gid * WGM, gsz = (nM - fm) < WGM ? (nM - fm) : WGM;
        u.pm = fm + ((wgid % nig) % gsz); u.pn = (wgid % nig) / gsz; return true;
    }
    __device__ __forceinline__ void a_ready(const Unit&) const {}
    __device__ __forceinline__ void done(const Unit&) const {}
};

__device__ __forceinline__ unsigned cvt_pk_bf16(float lo, float hi) { unsigned r; asm volatile("v_cvt_pk_bf16_f32 %0, %1, %2" : "=v"(r) : "v"(lo), "v"(hi)); return r; }
typedef float f32x2 __attribute__((ext_vector_type(2)));
__device__ __forceinline__ f32x2 gelu_pk(f32x2 v) {
    const f32x2 av = __builtin_elementwise_abs(v), d = av * 0.2316418882f + 1.0f;
    f32x2 t; t.x = __builtin_amdgcn_rcpf(d.x); t.y = __builtin_amdgcn_rcpf(d.y);
    f32x2 q = t * 0.5307027145f + (-0.7265760135f); q = q * t + 0.7107068705f; q = q * t + (-0.142248368f); q = q * t + 0.127414796f; q = q * t;
    const f32x2 s = (v * v) * (-0.72134752044f);
    f32x2 e; e.x = __builtin_amdgcn_exp2f(s.x); e.y = __builtin_amdgcn_exp2f(s.y);
    const f32x2 m = v * (q * e), r = v - m;
    f32x2 o; o.x = v.x < 0.f ? m.x : r.x; o.y = v.y < 0.f ? m.y : r.y; return o;
}

template <int ACT  > struct EpiBf16 {
    static constexpr bool PERM = true, AFTER_DRAIN = false; static_assert(ACT == 0 || ACT == 1, "EpiBf16: ACT is 0 (none) or 1 (gelu_pk)");
    bf16_t* O; int ldc; const float* bias; int split_cols; size_t split_stride; float scale0;
    __device__ __forceinline__ void operator()(const f32x4 (&acc)[2][2][4][2], const Unit& u, int wr, int wc, int fr, int fq) const {
        const int row0 = u.pm * BM + wr * 64 + fr; int colt = u.pn * BM; bf16_t* base = O;
        float sc = 1.f; if (split_cols) { const int t = colt / split_cols; base += (size_t)t * split_stride; colt -= t * split_cols; if (t == 0) sc = scale0; }
        const int col0 = colt + wc * 32 + 8 * fq, bcol0 = u.pn * BM + wc * 32 + 8 * fq;
        f32x4 bv[2][2];
#pragma unroll
        for (int bj = 0; bj < 2; ++bj)
#pragma unroll
            for (int n = 0; n < 2; ++n) bv[bj][n] = bias ? *(const f32x4*)(bias + bcol0 + bj * HALF + 4 * n) : (f32x4){0.f, 0.f, 0.f, 0.f};
#pragma unroll
        for (int ai = 0; ai < 2; ++ai)
#pragma unroll
            for (int m = 0; m < 4; ++m) { bf16_t* rowp = base + (size_t)(row0 + ai * HALF + m * 16) * ldc + col0;
#pragma unroll
                for (int bj = 0; bj < 2; ++bj) { f32x4 v0 = acc[ai][bj][m][0] + bv[bj][0], v1 = acc[ai][bj][m][1] + bv[bj][1];
                    if (ACT == 1) { f32x2 a = gelu_pk((f32x2){v0[0], v0[1]}), b = gelu_pk((f32x2){v0[2], v0[3]}), c = gelu_pk((f32x2){v1[0], v1[1]}), d = gelu_pk((f32x2){v1[2], v1[3]});
                        v0 = (f32x4){a.x, a.y, b.x, b.y}; v1 = (f32x4){c.x, c.y, d.x, d.y}; }
                    v0 = v0 * sc; v1 = v1 * sc; u32x4 w; w.x = cvt_pk_bf16(v0[0], v0[1]); w.y = cvt_pk_bf16(v0[2], v0[3]); w.z = cvt_pk_bf16(v1[0], v1[1]); w.w = cvt_pk_bf16(v1[2], v1[3]);
                    *(u32x4*)(rowp + bj * HALF) = w; } }
    }
};
struct EpiRes {
    static constexpr bool PERM = false, AFTER_DRAIN = false;
    const float* base; float* out; int ldc;
    __device__ __forceinline__ void operator()(const f32x4 (&acc)[2][2][4][2], const Unit& u, int wr, int wc, int fr, int fq) const {
        const int row0 = u.pm * BM + wr * 64 + fr, col0 = u.pn * BM + wc * 32 + 4 * fq;
#pragma unroll
        for (int ai = 0; ai < 2; ++ai)
#pragma unroll
            for (int m = 0; m < 4; ++m) { const size_t off = (size_t)(row0 + ai * HALF + m * 16) * ldc + col0;
#pragma unroll
                for (int bj = 0; bj < 2; ++bj)
#pragma unroll
                    for (int n = 0; n < 2; ++n) { const f32x4 b = *(const f32x4*)(base + off + bj * HALF + n * 16); *(f32x4*)(out + off + bj * HALF + n * 16) = b + acc[ai][bj][m][n]; }  asm volatile("" ::: "memory"); }
    }
};
struct EpiSwiglu {
    static constexpr bool PERM = true, AFTER_DRAIN = false;
    bf16_t* O; int ldo; const unsigned long long* ss; float inv_d, eps;
    static __device__ __forceinline__ float sg(float g, float u) { return g * u * __builtin_amdgcn_rcpf(1.0f + __builtin_amdgcn_exp2f(-1.4426950408889634f * g)); }
    __device__ __forceinline__ void operator()(const f32x4 (&acc)[2][2][4][2], const Unit& u, int wr, int wc, int fr, int fq) const {
        const int row0 = u.pm * BM + wr * 64 + fr, col0 = u.pn * HALF + wc * 32 + 8 * fq;
#pragma unroll
        for (int ai = 0; ai < 2; ++ai)
#pragma unroll
            for (int m = 0; m < 4; ++m) { const int row = row0 + ai * HALF + m * 16; bf16_t* rowp = O + (size_t)row * ldo + col0;
                const float r = __builtin_amdgcn_rsqf((float)ss[row] * inv_d + eps);
                const float a = -1.4426950408889634f * r, r2 = r * r;
                f32x4 o4[2];
#pragma unroll
                for (int n = 0; n < 2; ++n) { const f32x4 g = acc[ai][0][m][n], uu = acc[ai][1][m][n]; const f32x4 t = g * a;
                    f32x4 d; d[0] = __builtin_amdgcn_exp2f(t[0]); d[1] = __builtin_amdgcn_exp2f(t[1]); d[2] = __builtin_amdgcn_exp2f(t[2]); d[3] = __builtin_amdgcn_exp2f(t[3]);
                    d = d + 1.0f;
                    f32x4 iv; iv[0] = __builtin_amdgcn_rcpf(d[0]); iv[1] = __builtin_amdgcn_rcpf(d[1]); iv[2] = __builtin_amdgcn_rcpf(d[2]); iv[3] = __builtin_amdgcn_rcpf(d[3]);
                    o4[n] = (g * uu) * (iv * r2); }
                u32x4 w; w.x = cvt_pk_bf16(o4[0][0], o4[0][1]); w.y = cvt_pk_bf16(o4[0][2], o4[0][3]); w.z = cvt_pk_bf16(o4[1][0], o4[1][1]); w.w = cvt_pk_bf16(o4[1][2], o4[1][3]);
                *(u32x4*)rowp = w; }
    }
};


struct EpiResNorm {
    static constexpr bool PERM = false, AFTER_DRAIN = false;
    const float* base; float* out; bf16_t* xb; float* ss; int ldc;
    __device__ __forceinline__ void operator()(const f32x4 (&acc)[2][2][4][2], const Unit& u, int wr, int wc, int fr, int fq) const {
        const int row0 = u.pm * BM + wr * 64 + fr, col0 = u.pn * BM + wc * 32 + 4 * fq;
#pragma unroll
        for (int ai = 0; ai < 2; ++ai)
#pragma unroll
            for (int m = 0; m < 4; ++m) { const int row = row0 + ai * HALF + m * 16; const size_t off = (size_t)row * ldc + col0; float s = 0.f;
#pragma unroll
                for (int bj = 0; bj < 2; ++bj)
#pragma unroll
                    for (int n = 0; n < 2; ++n) { const f32x4 b = *(const f32x4*)(base + off + bj * HALF + n * 16); const f32x4 v = b + acc[ai][bj][m][n]; *(f32x4*)(out + off + bj * HALF + n * 16) = v;
                        s += (v[0] * v[0] + v[1] * v[1]) + (v[2] * v[2] + v[3] * v[3]);
                        unsigned long long w = (unsigned long long)cvt_pk_bf16(v[0], v[1]) | ((unsigned long long)cvt_pk_bf16(v[2], v[3]) << 32);
                        *(unsigned long long*)(xb + off + bj * HALF + n * 16) = w; }
                s += __shfl_xor(s, 16); s += __shfl_xor(s, 32);
                if (fq == 0) atomicAdd(ss + row, s);
                asm volatile("" ::: "memory"); }
    }
};
struct EpiProj {
    static constexpr bool PERM = true, AFTER_DRAIN = false;
    bf16_t* O; int ldc; int split_cols; size_t split_stride; float scale0; const unsigned long long* ss; float inv_d, eps;
    __device__ __forceinline__ void operator()(const f32x4 (&acc)[2][2][4][2], const Unit& u, int wr, int wc, int fr, int fq) const {
        const int row0 = u.pm * BM + wr * 64 + fr; int colt = u.pn * BM; bf16_t* base = O;
        float sc = 1.f; { const int t = colt / split_cols; base += (size_t)t * split_stride; colt -= t * split_cols; if (t == 0) sc = scale0; }
        const int col0 = colt + wc * 32 + 8 * fq;
#pragma unroll
        for (int ai = 0; ai < 2; ++ai)
#pragma unroll
            for (int m = 0; m < 4; ++m) { const int row = row0 + ai * HALF + m * 16; bf16_t* rowp = base + (size_t)row * ldc + col0;
                const float r = ss ? sc * __builtin_amdgcn_rsqf((float)ss[row] * inv_d + eps) : sc;
#pragma unroll
                for (int bj = 0; bj < 2; ++bj) { const f32x4 v0 = acc[ai][bj][m][0] * r, v1 = acc[ai][bj][m][1] * r;
                    u32x4 w; w.x = cvt_pk_bf16(v0[0], v0[1]); w.y = cvt_pk_bf16(v0[2], v0[3]); w.z = cvt_pk_bf16(v1[0], v1[1]); w.w = cvt_pk_bf16(v1[2], v1[3]);
                    *(u32x4*)(rowp + bj * HALF) = w; } }
    }
};

template <bool BASE_BF16, bool OUT_F32, bool WRITE_XB> struct EpiRes2 {
    static constexpr bool PERM = false, AFTER_DRAIN = false;
    const void* base; float* out; bf16_t* xb; unsigned long long* ss; int ldc;
    __device__ __forceinline__ void operator()(const f32x4 (&acc)[2][2][4][2], const Unit& u, int wr, int wc, int fr, int fq) const {
        const int row0 = u.pm * BM + wr * 64 + fr, col0 = u.pn * BM + wc * 32 + 4 * fq;
#pragma unroll
        for (int ai = 0; ai < 2; ++ai) {
            unsigned long long bw[4][2][2]; f32x4 bf[4][2][2];
#pragma unroll
            for (int m = 0; m < 4; ++m)
#pragma unroll
                for (int bj = 0; bj < 2; ++bj)
#pragma unroll
                    for (int n = 0; n < 2; ++n) { const size_t o2 = (size_t)(row0 + ai * HALF + m * 16) * ldc + col0 + bj * HALF + n * 16;
                        if (BASE_BF16) bw[m][bj][n] = *(const unsigned long long*)((const bf16_t*)base + o2); else bf[m][bj][n] = *(const f32x4*)((const float*)base + o2); }
            asm volatile("" ::: "memory");
#pragma unroll
            for (int m = 0; m < 4; ++m) { const int row = row0 + ai * HALF + m * 16; const size_t off = (size_t)row * ldc + col0; float s = 0.f;
#pragma unroll
                for (int bj = 0; bj < 2; ++bj)
#pragma unroll
                    for (int n = 0; n < 2; ++n) { const size_t o2 = off + bj * HALF + n * 16; f32x4 b;
                        if (BASE_BF16) { const unsigned long long w = bw[m][bj][n];
                            b = (f32x4){__uint_as_float((unsigned)w << 16), __uint_as_float((unsigned)w & 0xffff0000u), __uint_as_float((unsigned)(w >> 32) << 16), __uint_as_float((unsigned)(w >> 32) & 0xffff0000u)}; }
                        else b = bf[m][bj][n];
                        const f32x4 v = b + acc[ai][bj][m][n];
                        if (OUT_F32) *(f32x4*)(out + o2) = v;
                        s += (v[0] * v[0] + v[1] * v[1]) + (v[2] * v[2] + v[3] * v[3]);
                        if (WRITE_XB) *(unsigned long long*)(xb + o2) = (unsigned long long)cvt_pk_bf16(v[0], v[1]) | ((unsigned long long)cvt_pk_bf16(v[2], v[3]) << 32); }
                if (ss) { s += __shfl_xor(s, 16); s += __shfl_xor(s, 32); if (fq == 0) atomicAdd(ss + row, (unsigned long long)(s * 16777216.0f)); } }
            asm volatile("" ::: "memory");
        }
    }
};
template <class Epi, class Sched, bool ALIGN_EPI = false, bool SP2 = false>
__device__ __forceinline__ void gemm_phase(PG8_LAS unsigned char* lds, const Gemm g, const Sched& S, const Epi& E) {
    int tid_ = threadIdx.x; asm volatile("" : "+v"(tid_));
    const int tid = tid_, wid = __builtin_amdgcn_readfirstlane(tid >> 6), lane = tid & 63, wr = wid >> 2, wc = wid & 3, fr = lane & 15, fq = lane >> 4;
    const int K = g.K, nt = K / BK;
    unsigned voffA[2], voffB[2];
#pragma unroll
    for (int i = 0; i < 2; ++i) { int R, C; stage_rc(tid * 16 + i * 8192, R, C); const int Rb = Epi::PERM ? ((R & ~31) + perm32(R & 31)) : R;
        voffA[i] = (unsigned)(R * K + C) * 2u; voffB[i] = (unsigned)(Rb * K + C) * 2u; }
    const size_t kstep = (size_t)(BK * 2);
    const size_t hstep = (size_t)HALF * K * 2;
    const size_t tstep = 2 * hstep;
    const unsigned ldsw = (unsigned)wid * 1024u;
    const int aoff = lds_byte(wr * 64 + fr, fq * 8), boff = lds_byte(wc * 32 + fr, fq * 8);
#define PG8_SA(b, h) (((b) * 2 + (h)) * HTB)
#define PG8_SB(b, h) ((4 + (b) * 2 + (h)) * HTB)
#define PG8_STAGE(bufoff, gbase, voff) do { _Pragma("unroll") for (int _i = 0; _i < 2; ++_i) \
        __builtin_amdgcn_global_load_lds((const unsigned*)((const char*)(gbase) + (voff)[_i]), (PG8_LAS unsigned*)(lds + (bufoff) + ldsw + _i * 8192), 16, 0, 0); } while (0)
#define PG8_LDA(dst, b, h) do { _Pragma("unroll") for (int m = 0; m < 4; ++m) _Pragma("unroll") for (int k = 0; k < 2; ++k) dst[m][k] = *(const PG8_LAS bf16x8*)(lds + PG8_SA(b, h) + aoff + m * 2048 + k * 1024); } while (0)
#define PG8_LDB(dst, b, h) do { _Pragma("unroll") for (int n = 0; n < 2; ++n) _Pragma("unroll") for (int k = 0; k < 2; ++k) dst[n][k] = *(const PG8_LAS bf16x8*)(lds + PG8_SB(b, h) + boff + n * 2048 + k * 1024); } while (0)
#define PG8_MMA(ai, bj, At, Bt) do { __builtin_amdgcn_s_setprio(1); _Pragma("unroll") for (int m = 0; m < 4; ++m) _Pragma("unroll") for (int n = 0; n < 2; ++n) _Pragma("unroll") for (int k = 0; k < 2; ++k) \
        acc[ai][bj][m][n] = __builtin_amdgcn_mfma_f32_16x16x32_bf16(Bt[n][k], At[m][k], acc[ai][bj][m][n], 0, 0, 0); __builtin_amdgcn_s_setprio(0); } while (0)
#define PG8_WAIT_V(n) asm volatile("s_waitcnt vmcnt(" #n ")" ::: "memory")
#define PG8_WAIT_L(n) asm volatile("s_waitcnt lgkmcnt(" #n ")" ::: "memory")
#define PG8_BAR __builtin_amdgcn_s_barrier()
#define PG8_SCHED __builtin_amdgcn_sched_barrier(0)
    Unit cur, nxt; int ui = 0;
    if (!S.next(0, cur)) return;
    f32x4 acc[2][2][4][2];
#pragma unroll
    for (int a = 0; a < 2; ++a)
#pragma unroll
        for (int b = 0; b < 2; ++b)
#pragma unroll
            for (int m = 0; m < 4; ++m)
#pragma unroll
                for (int n = 0; n < 2; ++n) acc[a][b][m][n] = (f32x4){0.f, 0.f, 0.f, 0.f};
    bf16x8 At[4][2], B0[2][2], B1[2][2];
    const char* cA = (const char*)g.A + (size_t)cur.pm * tstep; const char* cB = (const char*)g.Bt + (size_t)cur.pn * tstep;
    S.a_ready(cur);
    if constexpr (SP2) {
        PG8_STAGE(PG8_SB(0, 0), cB, voffB); PG8_STAGE(PG8_SB(0, 1), cB + hstep, voffB); PG8_STAGE(PG8_SA(0, 0), cA, voffA); PG8_STAGE(PG8_SA(0, 1), cA + hstep, voffA);
        if (wr == 1) PG8_BAR;
        PG8_WAIT_V(2); PG8_BAR;
        PG8_STAGE(PG8_SB(1, 0), cB + kstep, voffB); PG8_STAGE(PG8_SA(1, 0), cA + kstep, voffA); PG8_STAGE(PG8_SB(1, 1), cB + hstep + kstep, voffB);
        PG8_WAIT_V(6); PG8_BAR;
    } else {
        PG8_STAGE(PG8_SB(0, 0), cB, voffB); PG8_STAGE(PG8_SA(0, 0), cA, voffA); PG8_STAGE(PG8_SB(0, 1), cB + hstep, voffB); PG8_STAGE(PG8_SA(0, 1), cA + hstep, voffA);
        if (wr == 1) PG8_BAR;
        PG8_WAIT_V(4); PG8_BAR;
        PG8_STAGE(PG8_SB(1, 0), cB + kstep, voffB); PG8_STAGE(PG8_SA(1, 0), cA + kstep, voffA); PG8_STAGE(PG8_SB(1, 1), cB + hstep + kstep, voffB);
        PG8_WAIT_V(6); PG8_BAR;
    }
    for (;;) {
        const bool has_next = S.next(ui + 1, nxt);
        const char* nA = has_next ? (const char*)g.A + (size_t)nxt.pm * tstep : cA; const char* nB = has_next ? (const char*)g.Bt + (size_t)nxt.pn * tstep : cB;
        for (int t = 0; t < nt; t += 2) {
            const bool last = (t == nt - 2);
            const char* a1 = cA + (size_t)(t + 1) * kstep;
            const char* a2 = last ? nA : cA + (size_t)(t + 2) * kstep; const char* b2 = last ? nB : cB + (size_t)(t + 2) * kstep;
            const char* a3 = a2 + kstep; const char* b3 = b2 + kstep;
            if (last && has_next) S.a_ready(nxt);
            if constexpr (SP2) {
            PG8_LDB(B0, 0, 0); PG8_LDB(B1, 0, 1); PG8_SCHED; PG8_LDA(At, 0, 0); PG8_STAGE(PG8_SA(1, 1), a1 + hstep, voffA);
            PG8_WAIT_V(8); PG8_WAIT_L(0); PG8_BAR; PG8_MMA(0, 0, At, B0); PG8_MMA(0, 1, At, B1); PG8_BAR; PG8_SCHED;
            PG8_LDA(At, 0, 1); PG8_STAGE(PG8_SB(0, 0), b2, voffB); PG8_STAGE(PG8_SB(0, 1), b2 + hstep, voffB); PG8_STAGE(PG8_SA(0, 0), a2, voffA);
            PG8_WAIT_V(8); PG8_WAIT_L(0); PG8_BAR; PG8_MMA(1, 0, At, B0); PG8_MMA(1, 1, At, B1); PG8_BAR; PG8_SCHED;
            PG8_LDB(B0, 1, 0); PG8_LDB(B1, 1, 1); PG8_SCHED; PG8_LDA(At, 1, 0); PG8_STAGE(PG8_SA(0, 1), a2 + hstep, voffA);
            PG8_WAIT_V(8); PG8_WAIT_L(0); PG8_BAR; PG8_MMA(0, 0, At, B0); PG8_MMA(0, 1, At, B1); PG8_BAR; PG8_SCHED;
            PG8_LDA(At, 1, 1); PG8_STAGE(PG8_SB(1, 0), b3, voffB); PG8_STAGE(PG8_SB(1, 1), b3 + hstep, voffB); PG8_STAGE(PG8_SA(1, 0), a3, voffA);
            PG8_WAIT_V(8); PG8_WAIT_L(0); PG8_BAR; PG8_MMA(1, 0, At, B0); PG8_MMA(1, 1, At, B1); PG8_BAR; PG8_SCHED;
            } else {
            PG8_LDB(B0, 0, 0); PG8_SCHED; PG8_LDA(At, 0, 0); PG8_STAGE(PG8_SA(1, 1), a1 + hstep, voffA);
            PG8_WAIT_L(8); PG8_BAR; PG8_WAIT_L(0); PG8_MMA(0, 0, At, B0); PG8_BAR; PG8_SCHED;
            PG8_LDB(B1, 0, 1); PG8_STAGE(PG8_SB(0, 0), b2, voffB);
            PG8_BAR; PG8_WAIT_L(0); PG8_MMA(0, 1, At, B1); PG8_BAR;
            PG8_LDA(At, 0, 1); PG8_STAGE(PG8_SA(0, 0), a2, voffA);
            PG8_BAR; PG8_WAIT_L(0); PG8_MMA(1, 0, At, B0); PG8_BAR; PG8_SCHED;
            PG8_STAGE(PG8_SB(0, 1), b2 + hstep, voffB);
            PG8_WAIT_V(6); PG8_BAR; PG8_MMA(1, 1, At, B1); PG8_BAR;
            PG8_LDB(B0, 1, 0); PG8_SCHED; PG8_LDA(At, 1, 0); PG8_STAGE(PG8_SA(0, 1), a2 + hstep, voffA);
            PG8_WAIT_L(8); PG8_BAR; PG8_WAIT_L(0); PG8_MMA(0, 0, At, B0); PG8_BAR; PG8_SCHED;
            PG8_LDB(B1, 1, 1); PG8_STAGE(PG8_SB(1, 0), b3, voffB);
            PG8_BAR; PG8_WAIT_L(0); PG8_MMA(0, 1, At, B1); PG8_BAR;
            PG8_LDA(At, 1, 1); PG8_STAGE(PG8_SA(1, 0), a3, voffA);
            PG8_BAR; PG8_WAIT_L(0); PG8_MMA(1, 0, At, B0); PG8_BAR; PG8_SCHED;
            PG8_STAGE(PG8_SB(1, 1), b3 + hstep, voffB);
            PG8_WAIT_V(6); PG8_BAR; PG8_MMA(1, 1, At, B1); PG8_BAR;
            }
        }
        if constexpr (ALIGN_EPI) { if (wr == 0) PG8_BAR; }
        if constexpr (!Epi::AFTER_DRAIN) { E(acc, cur, wr, wc, fr, fq); S.done(cur); }
        if (!has_next) break;
#pragma unroll
        for (int a = 0; a < 2; ++a)
#pragma unroll
            for (int b = 0; b < 2; ++b)
#pragma unroll
                for (int m = 0; m < 4; ++m)
#pragma unroll
                    for (int n = 0; n < 2; ++n) acc[a][b][m][n] = (f32x4){0.f, 0.f, 0.f, 0.f};
        cur = nxt; cA = nA; cB = nB; ++ui;
        if constexpr (ALIGN_EPI) { if (wr == 1) PG8_BAR; }
    }
    PG8_WAIT_V(0);
    if constexpr (!ALIGN_EPI) { if (wr == 0) PG8_BAR; }
    PG8_BAR;
    if constexpr (Epi::AFTER_DRAIN) { E.fused(acc, cur, wr, wc, fr, fq, lds, wid, lane); S.done(cur); }
#undef PG8_SA
#undef PG8_SB
#undef PG8_STAGE
#undef PG8_LDA
#undef PG8_LDB
#undef PG8_MMA
#undef PG8_WAIT_V
#undef PG8_WAIT_L
#undef PG8_BAR
#undef PG8_SCHED
}
}
namespace att {
#define ATT_LAS __attribute__((address_space(3)))
typedef unsigned short bf16_t;
typedef short bf16x8 __attribute__((ext_vector_type(8)));
typedef short s16x4 __attribute__((ext_vector_type(4)));
typedef short v4i16_t __attribute__((ext_vector_type(4)));
typedef float f32x16 __attribute__((ext_vector_type(16)));
typedef float f32x4 __attribute__((ext_vector_type(4)));
typedef unsigned u32x4 __attribute__((ext_vector_type(4)));
typedef float f32x2_t __attribute__((ext_vector_type(2)));
typedef __bf16 bf16x2_t __attribute__((ext_vector_type(2)));
constexpr int SEQ = 4096, PITCH = 2048, QB = 256, KVB = 64, TILE_BYTES = 16384;
constexpr int LDS_K = 0, LDS_V = 2 * TILE_BYTES, LDS_WS = 131072 + 2048, LDS_FLAG = LDS_WS + 8 * 256, LDS_BYTES = LDS_FLAG + 64;
constexpr float SB_DONE = -160.0f;
__device__ __forceinline__ unsigned off_b(unsigned row, unsigned ch) { return 256u * row + 16u * (ch ^ (((row & 3u) << 2) | ((row >> 2) & 3u))); }
__device__ __forceinline__ unsigned cvtpk(float lo, float hi) { f32x2_t v = {lo, hi}; bf16x2_t b = __builtin_convertvector(v, bf16x2_t); return __builtin_bit_cast(unsigned, b); }
__device__ __forceinline__ s16x4 vtr(const ATT_LAS unsigned char* p) { return __builtin_bit_cast(s16x4, __builtin_amdgcn_ds_read_tr16_b64_v4i16((ATT_LAS v4i16_t*)p)); }
#define ATT_MFMA(a, b, c) __builtin_amdgcn_mfma_f32_32x32x16_bf16((a), (b), (c), 0, 0, 0)

__device__ __forceinline__ const float* att_qgain();
__device__ __forceinline__ const float* att_rope();
template <int MODE, int NC, bool QROPE = false>
__device__ __forceinline__ void attn_unit(ATT_LAS unsigned char* lds, const bf16_t* __restrict__ Qp, const bf16_t* __restrict__ Kp, const bf16_t* __restrict__ Vp, void* Op, int q0) {
  int tid_ = threadIdx.x; asm volatile("" : "+v"(tid_));
  const int tid = tid_, lane = tid & 63, r32 = lane & 31, hi = lane >> 5;
  const int wid = __builtin_amdgcn_readfirstlane(tid >> 6);
  const int qrow0 = q0 + 32 * wid, t = qrow0 + r32;
  const int NT = (q0 + QB) / KVB;
  bf16x8 qf[8];
#pragma unroll
  for (int s = 0; s < 8; ++s) qf[s] = *(const bf16x8*)(Qp + (size_t)t * PITCH + 16 * s + 8 * hi);
  if (QROPE) {
    const float* __restrict__ qgain = att_qgain(); const float* __restrict__ rope = att_rope(); constexpr float qscale = 0.08838834764831845f * 1.4426950408889634f;
    float ss = 0.f;
#pragma unroll
    for (int s = 0; s < 8; ++s)
#pragma unroll
      for (int e = 0; e < 8; ++e) { const float v = __uint_as_float(((unsigned)(unsigned short)qf[s][e]) << 16); ss += v * v; }
    ss += __shfl_xor(ss, 32);
    const float rr = 1.0f / sqrtf(ss * (1.0f / 128.0f) + 1e-6f);
    const float* cs = rope + (size_t)t * 128;
#pragma unroll
    for (int s = 0; s < 4; ++s) {
      u32x4 wa, wb;
#pragma unroll
      for (int e = 0; e < 8; e += 2) {
        float oa[2], ob[2];
#pragma unroll
        for (int h2 = 0; h2 < 2; ++h2) { const int i = 16 * s + 8 * hi + e + h2;
          const float xa = __uint_as_float(((unsigned)(unsigned short)qf[s][e + h2]) << 16), xb = __uint_as_float(((unsigned)(unsigned short)qf[s + 4][e + h2]) << 16);
          const float ya = xa * rr * qgain[i], yb = xb * rr * qgain[64 + i], co = cs[2 * i], si = cs[2 * i + 1];
          oa[h2] = (ya * co - yb * si) * qscale; ob[h2] = (yb * co + ya * si) * qscale; }
        wa[e >> 1] = cvtpk(oa[0], oa[1]); wb[e >> 1] = cvtpk(ob[0], ob[1]);
      }
      qf[s] = __builtin_bit_cast(bf16x8, wa); qf[s + 4] = __builtin_bit_cast(bf16x8, wb);
    }
  }
  constexpr int VBUF = (NC / 4) * TILE_BYTES;
#define ATT_DMA(jt_, kbuf_, vbuf_) do { const size_t go_ = (size_t)(KVB * (jt_)) * PITCH; unsigned l_ = (unsigned)lane; asm volatile("" : "+v"(l_)); unsigned kgl[2]; \
    _Pragma("unroll") for (int i2 = 0; i2 < 2; ++i2) { const unsigned pc = 2u * wid + i2, rr = 4u * pc + (l_ >> 4), ch = (l_ & 15u) ^ (((l_ >> 4) & 3u) << 2 | (pc & 3u)); kgl[i2] = rr * PITCH + 8u * ch; } \
    _Pragma("unroll") for (int i2 = 0; i2 < 2; ++i2) { \
      __builtin_amdgcn_global_load_lds((const unsigned*)(Kp + go_ + kgl[i2]), (ATT_LAS unsigned*)(lds + LDS_K + (kbuf_) * TILE_BYTES + wid * 2048 + i2 * 1024), 16, 0, 0); \
      _Pragma("unroll") for (int hf = 0; hf < NC / 4; ++hf) \
        __builtin_amdgcn_global_load_lds((const unsigned*)(Vp + go_ + 128 * hf + kgl[i2]), (ATT_LAS unsigned*)(lds + LDS_V + (vbuf_) * VBUF + hf * TILE_BYTES + wid * 2048 + i2 * 1024), 16, 0, 0); } } while (0)
  const unsigned kbase = 256u * (unsigned)r32, kx = 16u * ((unsigned)hi ^ ((((unsigned)r32 & 3u) << 2) | (((unsigned)r32 >> 2) & 3u)));
  const unsigned vq = ((unsigned)lane & 15u) >> 2;
  unsigned vbase[2];
  { const unsigned p = (unsigned)lane & 3u, blk = ((unsigned)lane >> 4) & 1u, low = 2u * blk + (p >> 1);
#pragma unroll
    for (int jj = 0; jj < 2; ++jj) vbase[jj] = 256u * (8u * jj + 4u * hi + vq) + 16u * (low ^ (2u * jj + hi)) + 8u * (p & 1u); }
  ATT_LAS float* wsf = (ATT_LAS float*)(lds + LDS_WS) + wid * 64;
  ATT_LAS unsigned* flags = (ATT_LAS unsigned*)(lds + LDS_FLAG);
  f32x16 o[NC];
#pragma unroll
  for (int c = 0; c < NC; ++c)
#pragma unroll
    for (int r = 0; r < 16; ++r) o[c][r] = 0.f;
  float m_run = -INFINITY, l_run = 0.f, carry = 0.f;
  bool wdone = false;
  const bool lag = wid >= 4;
  bool pend = false; unsigned pvb = 0u;
  u32x4 pk[4];
#pragma unroll
  for (int s4 = 0; s4 < 4; ++s4) pk[s4] = (u32x4){0u, 0u, 0u, 0u};
#define ATT_PV(VB_) do { const ATT_LAS unsigned char* vb = (VB_); __builtin_amdgcn_s_setprio(1); \
    _Pragma("unroll") for (int s4 = 0; s4 < 4; ++s4) { const bf16x8 pa = __builtin_bit_cast(bf16x8, pk[s4]); \
      _Pragma("unroll") for (int c = 0; c < NC; ++c) { const unsigned vo = 64u * ((unsigned)(c & 3) ^ vq) + (c >> 2) * TILE_BYTES + 4096 * s4; \
        const s16x4 lo = vtr(vb + vbase[0] + vo), hh = vtr(vb + vbase[1] + vo); \
        const bf16x8 vf = __builtin_shufflevector(lo, hh, 0, 1, 2, 3, 4, 5, 6, 7); \
        o[c] = ATT_MFMA(pa, vf, o[c]); } \
      if (NC == 8) __builtin_amdgcn_sched_barrier(0); } \
    __builtin_amdgcn_s_setprio(0); } while (0)
  ATT_DMA(MODE == 0 ? NT - 1 : 0, 0, 0);
  asm volatile("s_waitcnt vmcnt(0)" ::: "memory");
  __syncthreads();
  int vcur = 0;
  for (int i = 0; i < NT; ++i) {
    const int jt = MODE == 0 ? NT - 1 - i : i; const int buf = i & 1; const int kv0 = KVB * jt;
    const bool more = i + 1 < NT;
    const int vnext = vcur == 2 ? 0 : vcur + 1;
    if (more) ATT_DMA(MODE == 0 ? jt - 1 : jt + 1, buf ^ 1, vnext);
    if (lag && pend) { ATT_PV(lds + LDS_V + pvb); pend = false; }
    const bool active = MODE == 0 ? (kv0 < qrow0 + 31 && !wdone) : (kv0 <= qrow0 + 31);
    f32x16 p0, p1;
    if (active) {
      const ATT_LAS unsigned char* kb = lds + LDS_K + buf * TILE_BYTES;
#pragma unroll
      for (int r = 0; r < 16; ++r) { p0[r] = 0.f; p1[r] = 0.f; }
      __builtin_amdgcn_s_setprio(1);
#pragma unroll
      for (int s = 0; s < 8; ++s) {
        const unsigned ko = kbase + ((32u * s) ^ kx);
        const bf16x8 k0 = *(const ATT_LAS bf16x8*)(kb + ko);
        const bf16x8 k1 = *(const ATT_LAS bf16x8*)(kb + ko + 8192);
        p0 = ATT_MFMA(k0, qf[s], p0); p1 = ATT_MFMA(k1, qf[s], p1);
      }
      __builtin_amdgcn_s_setprio(0);
      if (MODE == 1) {
        const bool full = (kv0 + 63 <= qrow0);
        if (!full) {
#pragma unroll
          for (int r = 0; r < 16; ++r) { const int kv = kv0 + (r & 3) + 8 * (r >> 2) + 4 * hi; if (kv > t) p0[r] = -INFINITY; if (kv + 32 > t) p1[r] = -INFINITY; }
        }
        float mx = __builtin_fmaxf(__builtin_fmaxf(p0[0], p1[0]), __builtin_fmaxf(p0[1], p1[1]));
#pragma unroll
        for (int r = 2; r < 16; r += 2) mx = __builtin_fmaxf(__builtin_fmaxf(mx, __builtin_fmaxf(p0[r], p1[r])), __builtin_fmaxf(p0[r + 1], p1[r + 1]));
        mx = fmaxf(mx, __shfl_xor(mx, 32));
        float alpha = 1.0f;
        const bool upd = __builtin_amdgcn_ballot_w64(mx > m_run + 8.0f) != 0ull;
        if (upd) { const float m_new = fmaxf(m_run, mx); alpha = __builtin_amdgcn_exp2f(m_run - m_new); m_run = m_new; }
        float rs = 0.f;
#pragma unroll
        for (int r = 0; r < 16; ++r) { p0[r] = __builtin_amdgcn_exp2f(p0[r] - m_run); p1[r] = __builtin_amdgcn_exp2f(p1[r] - m_run); rs += p0[r] + p1[r]; }
        l_run = l_run * alpha + rs;
        if (upd) {
          if (hi == 0) wsf[r32] = alpha;
#pragma unroll
          for (int g = 0; g < 4; ++g) { const f32x4 a4 = *(const ATT_LAS f32x4*)(wsf + 8 * g + 4 * hi);
#pragma unroll
            for (int c = 0; c < NC; ++c)
#pragma unroll
              for (int e = 0; e < 4; ++e) o[c][4 * g + e] *= a4[e]; }
        }
      } else {
        const bool full = (kv0 + 63 < qrow0);
        float l1a[16], l1b[16];
#pragma unroll
        for (int r = 0; r < 16; ++r) {
          const int kv = kv0 + (r & 3) + 8 * (r >> 2) + 4 * hi;
          { const float z = p0[r]; const float e = __builtin_amdgcn_exp2f(-fabsf(z)); const float lg = __builtin_amdgcn_logf(1.0f + e);
            float v = -(fmaxf(z, 0.f) + lg); if (!full && !(kv < t)) v = 0.f; l1a[r] = v; }
          { const float z = p1[r]; const float e = __builtin_amdgcn_exp2f(-fabsf(z)); const float lg = __builtin_amdgcn_logf(1.0f + e);
            float v = -(fmaxf(z, 0.f) + lg); if (!full && !(kv + 32 < t)) v = 0.f; l1b[r] = v; }
        }
        float SM[9], SP[9]; SM[8] = 0.f; SP[8] = 0.f;
#pragma unroll
        for (int g = 3; g >= 0; --g) SM[4 + g] = ((l1b[4 * g] + l1b[4 * g + 1]) + (l1b[4 * g + 2] + l1b[4 * g + 3])) + SM[5 + g];
#pragma unroll
        for (int g = 3; g >= 0; --g) SM[g] = ((l1a[4 * g] + l1a[4 * g + 1]) + (l1a[4 * g + 2] + l1a[4 * g + 3])) + SM[1 + g];
#pragma unroll
        for (int i2 = 0; i2 < 8; ++i2) SP[i2] = __shfl_xor(SM[i2], 32);
#pragma unroll
        for (int i2 = 0; i2 < 8; ++i2) {
          float later = carry + SM[i2 + 1] + (hi ? SP[i2 + 1] : SP[i2]);
#pragma unroll
          for (int e = 3; e >= 0; --e) {
            const int r = 4 * (i2 & 3) + e; const int kv = kv0 + 32 * (i2 >> 2) + e + 8 * (i2 & 3) + 4 * hi;
            const float z = (i2 >> 2) ? p1[r] : p0[r]; const float l1 = (i2 >> 2) ? l1b[r] : l1a[r];
            float a = __builtin_amdgcn_exp2f(z + l1 + later); if (!full && !(kv < t)) a = 0.f;
            if (i2 >> 2) p1[r] = a; else p0[r] = a;
            later += l1;
          }
        }
        carry += SM[0] + SP[0];
        wdone = (__builtin_amdgcn_ballot_w64(carry >= SB_DONE) == 0ull);
      }
    }
    if (active) {
      pk[0] = (u32x4){cvtpk(p0[0], p0[1]), cvtpk(p0[2], p0[3]), cvtpk(p0[4], p0[5]), cvtpk(p0[6], p0[7])};
      pk[1] = (u32x4){cvtpk(p0[8], p0[9]), cvtpk(p0[10], p0[11]), cvtpk(p0[12], p0[13]), cvtpk(p0[14], p0[15])};
      pk[2] = (u32x4){cvtpk(p1[0], p1[1]), cvtpk(p1[2], p1[3]), cvtpk(p1[4], p1[5]), cvtpk(p1[6], p1[7])};
      pk[3] = (u32x4){cvtpk(p1[8], p1[9]), cvtpk(p1[10], p1[11]), cvtpk(p1[12], p1[13]), cvtpk(p1[14], p1[15])};
      if (lag) { pend = true; pvb = (unsigned)(vcur * VBUF); }
      else ATT_PV(lds + LDS_V + vcur * VBUF);
    }
    vcur = vnext;
    if (MODE == 0) { if (lane == 0) flags[(i & 1) * 8 + wid] = wdone ? 1u : 0u; }
    asm volatile("s_waitcnt vmcnt(0)" ::: "memory");
    __syncthreads();
    if (MODE == 0) {
      const u32x4 fa = *(const ATT_LAS u32x4*)(flags + (i & 1) * 8), fb = *(const ATT_LAS u32x4*)(flags + (i & 1) * 8 + 4);
      const unsigned all = fa[0] & fa[1] & fa[2] & fa[3] & fb[0] & fb[1] & fb[2] & fb[3];
      if (__builtin_amdgcn_readfirstlane(all) != 0u) break;
    }
  }
  if (lag && pend) ATT_PV(lds + LDS_V + pvb);
  if (MODE == 1) {
    const float l = l_run + __shfl_xor(l_run, 32);
    if (hi == 0) wsf[r32] = 1.0f / l;
    bf16_t* O = (bf16_t*)Op;
#pragma unroll
    for (int g = 0; g < 4; ++g) { const f32x4 i4 = *(const ATT_LAS f32x4*)(wsf + 8 * g + 4 * hi);
#pragma unroll
      for (int e = 0; e < 4; ++e) { bf16_t* orow = O + (size_t)(qrow0 + 8 * g + 4 * hi + e) * PITCH + r32;
#pragma unroll
        for (int c = 0; c < NC; ++c) orow[32 * c] = (bf16_t)(cvtpk(o[c][4 * g + e] * i4[e], 0.f) & 0xffffu); } }
  } else {
    bf16_t* O = (bf16_t*)Op;
#pragma unroll
    for (int g = 0; g < 4; ++g)
#pragma unroll
      for (int e = 0; e < 4; ++e) { bf16_t* orow = O + (size_t)(qrow0 + 8 * g + 4 * hi + e) * PITCH + r32;
#pragma unroll
        for (int c = 0; c < NC; ++c) orow[32 * c] = (bf16_t)(cvtpk(o[c][4 * g + e], 0.f) & 0xffffu); }
  }
  __syncthreads();
}
#undef ATT_MFMA
#undef ATT_DMA
#undef ATT_PV
}
#define GAS __attribute__((address_space(1)))
#define LAS __attribute__((address_space(3)))
typedef unsigned short bf16;
typedef unsigned v4u __attribute__((ext_vector_type(4)));
typedef float f32x4 __attribute__((ext_vector_type(4)));
typedef short bf16x8 __attribute__((ext_vector_type(8)));
typedef GAS unsigned gu32;
typedef GAS unsigned long long gu64;
#define RLX_AGENT __ATOMIC_RELAXED, __HIP_MEMORY_SCOPE_AGENT
#define LDS_WAIT() asm volatile("s_waitcnt lgkmcnt(0)" ::: "memory")
#define VM_WAIT() asm volatile("s_waitcnt vmcnt(0)" ::: "memory")
__device__ __forceinline__ unsigned long long rt() { return __builtin_amdgcn_s_memrealtime(); }
__device__ __forceinline__ unsigned f2bf(float f) { unsigned u = __builtin_bit_cast(unsigned, f); return (u + 0x7fffu + ((u >> 16) & 1u)) >> 16; }
__device__ __forceinline__ unsigned pk2(float lo, float hi) { return f2bf(lo) | (f2bf(hi) << 16); }

#define XB_TMO      128
#define XB_XCNT(j)  (256  + 64 * (j))
#define XB_XSUB(j)  (1280 + 64 * (j))
#define XB_XGEN(j)  (2304 + 64 * (j))
#define XB_TOP      3328
#define XB_TOPGEN   3392
#define XCD_BAR_WORDS 3456
#define XB_SPIN_CAP (1u << 18)

__device__ __forceinline__ unsigned xb_ld(unsigned* p)              { return __hip_atomic_load(p, __ATOMIC_RELAXED, __HIP_MEMORY_SCOPE_AGENT); }
__device__ __forceinline__ unsigned xb_add(unsigned* p, unsigned v) { return __hip_atomic_fetch_add(p, v, __ATOMIC_RELAXED, __HIP_MEMORY_SCOPE_AGENT); }
__device__ __forceinline__ unsigned xb_xcc_id() { return (unsigned)__builtin_amdgcn_s_getreg((3 << 11) | 20) & 0xFu; }
#define XB_SPIN(cond, bar) do { unsigned _sp = 0; while (cond) { __builtin_amdgcn_s_sleep(1); \
    if ((++_sp & 255u) == 0u) { if (xb_ld(&(bar)[XB_TMO])) break; if (_sp > XB_SPIN_CAP) { atomicAdd(&(bar)[XB_TMO], 1u); break; } } } } while (0)

struct XcdBarrier {
    unsigned* bar; unsigned x;
    volatile LAS unsigned* st;
};

__device__ __forceinline__ XcdBarrier xcd_barrier_post(unsigned* bar, volatile LAS unsigned* st) {
    XcdBarrier b; b.bar = bar; b.x = xb_xcc_id(); b.st = st;
    if (threadIdx.x == 0) (void)xb_add(&bar[XB_XCNT(b.x)], 1u);
    return b;
}
__device__ __forceinline__ void xcd_barrier_complete(unsigned* bar, unsigned x, unsigned& nloc, unsigned& nx) {
    const unsigned G = gridDim.x * gridDim.y * gridDim.z;
    unsigned sum, cnt, mine, sp = 0u;
    for (;;) {
        sum = 0u; cnt = 0u; mine = 0u;
#pragma unroll
        for (unsigned j = 0; j < 16; ++j) { const unsigned c = xb_ld(&bar[XB_XCNT(j)]); sum += c; cnt += (c > 0u) ? 1u : 0u; mine = (j == x) ? c : mine; }
        if (sum == G) break;
        __builtin_amdgcn_s_sleep(1);
        if ((++sp & 255u) == 0u) { if (xb_ld(&bar[XB_TMO])) break; if (sp > XB_SPIN_CAP) { atomicAdd(&bar[XB_TMO], 1u); break; } }
    }
    nloc = mine > 0u ? mine : 1u; nx = cnt > 0u ? cnt : 1u;
}

__device__ __forceinline__ void xcd_barrier(const XcdBarrier& b) {
    asm volatile("s_waitcnt vmcnt(0)" ::: "memory");
    __syncthreads();
    if (threadIdx.x == 0) {
        unsigned* bar = b.bar;
        __builtin_amdgcn_s_waitcnt(0);
        unsigned nloc = b.st[0], nx = b.st[1];
        if (nloc == 0u) { xcd_barrier_complete(bar, b.x, nloc, nx); b.st[0] = nloc; b.st[1] = nx; }
        const unsigned old = xb_add(&bar[XB_XSUB(b.x)], 1u);
        const unsigned gen = old / nloc;
        if (old + 1u == (gen + 1u) * nloc) {
            __builtin_amdgcn_fence(__ATOMIC_RELEASE, "agent");
            asm volatile("s_waitcnt vmcnt(0)" ::: "memory");
            const unsigned og = xb_add(&bar[XB_TOP], 1u);
            const unsigned tg = og / nx;
            if (og + 1u == (tg + 1u) * nx) xb_add(&bar[XB_TOPGEN], 1u);
            else XB_SPIN(xb_ld(&bar[XB_TOPGEN]) == tg, bar);
            __builtin_amdgcn_fence(__ATOMIC_ACQUIRE, "agent");
            xb_add(&bar[XB_XGEN(b.x)], 1u);
            asm volatile("s_waitcnt vmcnt(0)" ::: "memory");
        } else {
            XB_SPIN(xb_ld(&bar[XB_XGEN(b.x)]) == gen, bar);
            __builtin_amdgcn_fence(__ATOMIC_ACQUIRE, "agent");
            asm volatile("s_waitcnt vmcnt(0)" ::: "memory");
        }
    }
    __syncthreads();
}
constexpr int NWAVES = 8;
constexpr int BATCH = 2, SEQ = 4096, D = 2048, M = BATCH * SEQ, FF = 5632, NPROJ = 6144;
constexpr float EPS = 1e-6f;
constexpr float C2 = 0.08838834764831845f * 1.4426950408889634f;
constexpr float LAMBDA_INIT = 0.35550906759f;
constexpr size_t MiB = 1u << 20;
constexpr size_t WS_CTL = 0, CTL_ZERO_BYTES = 65536 + 3 * 65536;
constexpr size_t WS_SS = 65536;
constexpr size_t WS_ROPE = 1 * MiB;
constexpr size_t WS_WKVQ = 4 * MiB, WS_WO_B = 28 * MiB, WS_WGU_B = 36 * MiB, WS_WD_B = 80 * MiB;
constexpr size_t WS_AB = 102 * MiB;
constexpr size_t WS_P0 = 134 * MiB, WS_P1 = 166 * MiB, WS_P2 = 198 * MiB;
constexpr size_t WS_ACT = 230 * MiB;
constexpr size_t WS_WQKV_A = 318 * MiB, WS_WO_A = 342 * MiB, WS_WGU_A = 350 * MiB, WS_WD_A = 394 * MiB;
constexpr size_t WS_OB = 318 * MiB;
constexpr size_t WS_XB = 416 * MiB;
constexpr size_t WS_END = 448 * MiB;
constexpr int CW_BAR = 1024;
constexpr int RING_BYTES = 131072, LDSCTL_OFF = RING_BYTES, MISC_OFF = LDSCTL_OFF + 320, LDS_BYTES = 147456;
static_assert(att::LDS_BYTES <= LDS_BYTES && att::LDS_WS >= MISC_OFF + 128 && (2 + 3 * 2) * att::TILE_BYTES <= RING_BYTES && (3 + 4) * att::TILE_BYTES <= RING_BYTES, "attention LDS");

__device__ __forceinline__ float wave_sum(float v) {
#pragma unroll
    for (int o = 1; o < 64; o <<= 1) v += __shfl_xor(v, o);
    return v;
}
__device__ __forceinline__ void transpose_item(const float* __restrict__ W, int K, int N, bf16* WT, int row_off, int gu_map, const float* __restrict__ gain, LAS float* scr, int item, int lane) {
    const int nblk = N / 32, kb = item / nblk, nb = item - kb * nblk, k0 = 64 * kb, n0 = 32 * nb;
    float wv[32];
#pragma unroll
    for (int i = 0; i < 32; ++i) { const int kk = 2 * i + (lane >> 5); wv[i] = __builtin_nontemporal_load(W + (size_t)(k0 + kk) * N + n0 + (lane & 31)); }
    if (gain) {
#pragma unroll
        for (int i = 0; i < 32; ++i) wv[i] *= gain[k0 + 2 * i + (lane >> 5)];
    }
#pragma unroll
    for (int i = 0; i < 32; ++i) scr[(2 * i + (lane >> 5)) * 33 + (lane & 31)] = wv[i];
    LDS_WAIT(); asm volatile("" ::: "memory");
    int drow0 = row_off + n0;
    if (gu_map) { const int half = N / 2, isup = n0 >= half ? 1 : 0, j = n0 - isup * half; drow0 = 256 * (j >> 7) + 128 * isup + (j & 127); }
    const int c = lane & 7;
#pragma unroll
    for (int j = 0; j < 4; ++j) { const int n = (lane >> 3) + 8 * j; const LAS float* s = scr + (8 * c) * 33 + n;
        v4u o; o.x = pk2(s[0 * 33], s[1 * 33]); o.y = pk2(s[2 * 33], s[3 * 33]); o.z = pk2(s[4 * 33], s[5 * 33]); o.w = pk2(s[6 * 33], s[7 * 33]);
        *(GAS v4u*)(WT + (size_t)(drow0 + n) * K + k0 + 8 * c) = o; }
    LDS_WAIT(); asm volatile("" ::: "memory");
}
__device__ __forceinline__ void xb_rows(const float* X, bf16* out, unsigned long long* ss, int gw, int NGW, int lane) {
    for (int m = gw; m < M; m += NGW) {
        const GAS f32x4* xr = (const GAS f32x4*)(X + (size_t)m * D) + lane;
        f32x4 v[8]; float s = 0.f;
#pragma unroll
        for (int j = 0; j < 8; ++j) { v[j] = xr[64 * j]; s += (v[j].x * v[j].x + v[j].y * v[j].y) + (v[j].z * v[j].z + v[j].w * v[j].w); }
        s = wave_sum(s);
        if (lane == 0) ss[m] = (unsigned long long)(s * 16777216.0f);
        GAS unsigned long long* o8 = (GAS unsigned long long*)(out + (size_t)m * D) + lane;
#pragma unroll
        for (int j = 0; j < 8; ++j) o8[64 * j] = (unsigned long long)pk2(v[j].x, v[j].y) | ((unsigned long long)pk2(v[j].z, v[j].w) << 32);
    }
}
__device__ __forceinline__ void rms_rows(const float* X, bf16* out, int gw, int NGW, int lane) {
    for (int m = gw; m < M; m += NGW) {
        const GAS f32x4* xr = (const GAS f32x4*)(X + (size_t)m * D) + lane;
        f32x4 v[8]; float s = 0.f;
#pragma unroll
        for (int j = 0; j < 8; ++j) { v[j] = xr[64 * j]; s += (v[j].x * v[j].x + v[j].y * v[j].y) + (v[j].z * v[j].z + v[j].w * v[j].w); }
        const float r = 1.0f / sqrtf(wave_sum(s) * (1.0f / D) + EPS);
        GAS unsigned long long* o8 = (GAS unsigned long long*)(out + (size_t)m * D) + lane;
#pragma unroll
        for (int j = 0; j < 8; ++j) o8[64 * j] = (unsigned long long)pk2(v[j].x * r, v[j].y * r) | ((unsigned long long)pk2(v[j].z * r, v[j].w * r) << 32);
    }
}
__device__ __forceinline__ float bf2f(unsigned short h) { return __uint_as_float(((unsigned)h) << 16); }
__device__ __forceinline__ void qknorm_rope_row(bf16* row, const float* __restrict__ gain, float sc, const float* __restrict__ cs  , int lane) {
    const int cc = lane & 7;
    float ga[8], gb[8], co[8], si[8];
#pragma unroll
    for (int e = 0; e < 8; ++e) { ga[e] = gain[8 * cc + e]; gb[e] = gain[64 + 8 * cc + e]; co[e] = cs[2 * (8 * cc + e)]; si[e] = cs[2 * (8 * cc + e) + 1]; }
#pragma unroll
    for (int it = 0; it < 2; ++it) {
        bf16* p = row + 128 * (8 * it + (lane >> 3)) + 8 * cc;
        const v4u a = *(const GAS v4u*)p, b = *(const GAS v4u*)(p + 64);
        float xa[8], xb[8]; float ss = 0.f;
#pragma unroll
        for (int e = 0; e < 4; ++e) { xa[2 * e] = __uint_as_float(a[e] << 16); xa[2 * e + 1] = __uint_as_float(a[e] & 0xffff0000u); xb[2 * e] = __uint_as_float(b[e] << 16); xb[2 * e + 1] = __uint_as_float(b[e] & 0xffff0000u); }
#pragma unroll
        for (int e = 0; e < 8; ++e) ss += xa[e] * xa[e] + xb[e] * xb[e];
        ss += __shfl_xor(ss, 1); ss += __shfl_xor(ss, 2); ss += __shfl_xor(ss, 4);
        const float r = 1.0f / sqrtf(ss * (1.0f / 128.0f) + EPS);
        float oa[8], ob[8];
#pragma unroll
        for (int e = 0; e < 8; ++e) { const float ya = xa[e] * r * ga[e], yb = xb[e] * r * gb[e]; oa[e] = (ya * co[e] - yb * si[e]) * sc; ob[e] = (yb * co[e] + ya * si[e]) * sc; }
        v4u wa, wb;
#pragma unroll
        for (int e = 0; e < 4; ++e) { wa[e] = pk2(oa[2 * e], oa[2 * e + 1]); wb[e] = pk2(ob[2 * e], ob[2 * e + 1]); }
        *(GAS v4u*)p = wa; *(GAS v4u*)(p + 64) = wb;
    }
}

struct Args { const float* in[22]; float* out; unsigned char* ws; };
typedef __attribute__((address_space(4))) const Args* ArgsCP;
__device__ __forceinline__ ArgsCP argp() { ArgsCP p = (ArgsCP)__builtin_amdgcn_kernarg_segment_ptr(); asm volatile("" : "+s"(p)); return p; }


#ifndef MK_CG_ALL
#define MK_CG_ALL 0
#endif
#if MK_CG_ALL
#define GSYNC() cg::this_grid().sync()
#else
#define GSYNC() do { XcdBarrier b_; b_.bar = (unsigned*)((gu32*)(argp()->ws + WS_CTL) + CW_BAR); b_.x = xb_xcc_id(); b_.st = (volatile LAS unsigned*)(lds + MISC_OFF) + 8; xcd_barrier(b_); } while (0)
#endif
__device__ __forceinline__ int opaque_tid() { int t = threadIdx.x; asm volatile("" : "+v"(t)); return t; }
namespace att {
__device__ __forceinline__ const float* att_qgain() { return argp()->in[12]; }
__device__ __forceinline__ const float* att_rope() { return (const float*)(argp()->ws + WS_ROPE); }
}
template <int L>
__device__ __forceinline__ void layer_body(LAS unsigned char* lds, unsigned char* ws, const float* x, float* out,
                                           int G, int bx, int vcu, int gw, int NGW) {
    bf16* AB = (bf16*)(ws + WS_AB); bf16* P0 = (bf16*)(ws + WS_P0); bf16* P1 = (bf16*)(ws + WS_P1); bf16* P2 = (bf16*)(ws + WS_P2);
    bf16* ACT = (bf16*)(ws + WS_ACT); bf16* OB = (bf16*)(ws + WS_OB); float* ROPE = (float*)(ws + WS_ROPE);
        bf16* XB = (bf16*)(ws + WS_XB); unsigned long long* SS = (unsigned long long*)(ws + WS_SS);
        {
            pg8::Gemm g{XB, (const bf16*)(ws + (L == 0 ? WS_WQKV_A : WS_WKVQ)), M, NPROJ, D}; pg8::StaticOrder S; S.init(M, NPROJ, G, bx);
            pg8::EpiProj E{P0, D, D, (size_t)(WS_P1 - WS_P0) / 2, L == 0 ? C2 : 1.0f, L == 0 ? SS + 3 * (size_t)M : SS + M, (1.0f / D) * (1.0f / 16777216.0f), EPS};
            pg8::gemm_phase<pg8::EpiProj, pg8::StaticOrder, true, true>(lds, g, S, E);
        }
        GSYNC();
        if constexpr (L == 0) {
            constexpr int TOTAL = 32 * 16; const int per = (TOTAL + G - 1) / G;
            for (int idx = vcu * per; idx < (vcu + 1) * per && idx < TOTAL; ++idx) {
                const int hp = idx >> 4, k = idx & 15, qb = (k & 1) ? 15 - (k >> 1) : (k >> 1);
                const size_t base = (size_t)(hp >> 4) * SEQ * D + 128 * (hp & 15);
                att::attn_unit<0, 4>(lds, P0 + base, P1 + base, P2 + base, (void*)(AB + base), qb * att::QB);
            }
            GSYNC();
        } else {
            const int lane = opaque_tid() & 63;
            for (int m = gw; m < M; m += NGW) qknorm_rope_row(P0 + (size_t)m * D, argp()->in[9], 1.0f, ROPE + (size_t)(m & (SEQ - 1)) * 128, lane);
            GSYNC();
            constexpr int TOTAL = 32 * 16; const int per = (TOTAL + G - 1) / G;
            for (int idx = vcu * per; idx < (vcu + 1) * per && idx < TOTAL; ++idx) {
                const int hp = idx >> 4, k = idx & 15, qb = (k & 1) ? 15 - (k >> 1) : (k >> 1);
                const int c = hp & 1, h = (hp >> 1) & 7, b = hp >> 4;
                const size_t rb = (size_t)b * SEQ * D;
                att::attn_unit<1, 8, true>(lds, P2 + rb + (2 * h + c) * 128, P0 + rb + (2 * h + c) * 128, P1 + rb + 256 * h, (void*)(OB + (size_t)c * M * D + rb + 256 * h), qb * att::QB);
            }
            GSYNC();
            {
                const int lane = opaque_tid() & 63;
                const float a1 = argp()->in[13][lane] * argp()->in[14][lane] + argp()->in[13][lane + 64] * argp()->in[14][lane + 64];
                const float a2 = argp()->in[15][lane] * argp()->in[16][lane] + argp()->in[15][lane + 64] * argp()->in[16][lane + 64];
                const float lam = expf(wave_sum(a1)) - expf(wave_sum(a2)) + LAMBDA_INIT;
                const f32x4 gs = *(const GAS f32x4*)(argp()->in[17] + 4 * lane);
                for (int m = gw; m < M; m += NGW) {
#pragma unroll
                    for (int h = 0; h < 8; ++h) {
                        const size_t off = (size_t)m * D + 256 * h + 4 * lane;
                        const unsigned long long w0 = *(const GAS unsigned long long*)(OB + off), w1 = *(const GAS unsigned long long*)(OB + (size_t)M * D + off);
                        const f32x4 o0 = {__uint_as_float((unsigned)w0 << 16), __uint_as_float((unsigned)w0 & 0xffff0000u), __uint_as_float((unsigned)(w0 >> 32) << 16), __uint_as_float((unsigned)(w0 >> 32) & 0xffff0000u)};
                        const f32x4 o1 = {__uint_as_float((unsigned)w1 << 16), __uint_as_float((unsigned)w1 & 0xffff0000u), __uint_as_float((unsigned)(w1 >> 32) << 16), __uint_as_float((unsigned)(w1 >> 32) & 0xffff0000u)};
                        const f32x4 o = o0 - lam * o1;
                        const float ss = wave_sum((o.x * o.x + o.y * o.y) + (o.z * o.z + o.w * o.w));
                        const float r = (1.0f - LAMBDA_INIT) / sqrtf(ss * (1.0f / 256.0f) + EPS);
                        *(GAS unsigned long long*)(AB + off) = (unsigned long long)pk2(o.x * r * gs.x, o.y * r * gs.y) | ((unsigned long long)pk2(o.z * r * gs.z, o.w * r * gs.w) << 32);
                    }
                }
            }
            GSYNC();
        }
        {
            pg8::Gemm g{AB, (const bf16*)(ws + (L == 0 ? WS_WO_A : WS_WO_B)), M, D, D}; pg8::StaticOrder S; S.init(M, D, G, bx);
            { pg8::EpiRes2<true, false, true> E{(const void*)XB, nullptr, XB, SS + (L == 0 ? 0 : 2 * M), D}; pg8::gemm_phase<pg8::EpiRes2<true, false, true>, pg8::StaticOrder, true, true>(lds, g, S, E); }
        }
        GSYNC();
        {
            pg8::Gemm g{XB, (const bf16*)(ws + (L == 0 ? WS_WGU_A : WS_WGU_B)), M, 2 * FF, D}; pg8::StaticOrder S; S.init(M, 2 * FF, G, bx);
            pg8::EpiSwiglu E{ACT, FF, SS + (L == 0 ? 0 : 2 * M), (1.0f / D) * (1.0f / 16777216.0f), EPS};
            pg8::gemm_phase<pg8::EpiSwiglu, pg8::StaticOrder, true, true>(lds, g, S, E);
            if constexpr (L == 0) {
                if (G == 256 && bx >= 128) {
                    const int t_ = opaque_tid(), lane = t_ & 63, wave = __builtin_amdgcn_readfirstlane(t_ >> 6);
                    LAS float* scr = (LAS float*)(lds + wave * 16384);
                    for (int it = (bx - 128) * NWAVES + wave; it < 32 * 352; it += 128 * NWAVES) transpose_item(argp()->in[20], D, 2 * FF, (bf16*)(ws + WS_WGU_B), 0, 1, argp()->in[19], scr, it, lane);
                }
            } else {
                if (G == 256 && bx >= 128) {
                    const int t_ = opaque_tid(), lane = t_ & 63, wave = __builtin_amdgcn_readfirstlane(t_ >> 6);
                    LAS float* scr = (LAS float*)(lds + wave * 16384);
                    for (int it = (bx - 128) * NWAVES + wave; it < 88 * 64; it += 128 * NWAVES) transpose_item(argp()->in[21], FF, D, (bf16*)(ws + WS_WD_B), 0, 0, nullptr, scr, it, lane);
                }
            }
        }
        GSYNC();
        {
            pg8::Gemm g{ACT, (const bf16*)(ws + (L == 0 ? WS_WD_A : WS_WD_B)), M, D, FF}; pg8::StaticOrder S; S.init(M, D, G, bx);
            if constexpr (L == 0) { pg8::EpiRes2<true, false, true> E{(const void*)XB, nullptr, XB, SS + M, D}; pg8::gemm_phase<pg8::EpiRes2<true, false, true>, pg8::StaticOrder, true, true>(lds, g, S, E); }
            else { pg8::EpiRes2<true, true, false> E{(const void*)XB, out, nullptr, nullptr, D}; pg8::gemm_phase<pg8::EpiRes2<true, true, false>, pg8::StaticOrder, true, true>(lds, g, S, E); }
        }
        if (L == 0) GSYNC();
}

__global__ void __launch_bounds__(NWAVES * 64, 2) fwd_megakernel(Args args) {
    extern __shared__ __attribute__((aligned(16))) unsigned char lds_raw[];
    LAS unsigned char* lds = (LAS unsigned char*)lds_raw;
    volatile LAS unsigned* MISC = (volatile LAS unsigned*)(lds + MISC_OFF);
    const int tid = threadIdx.x, lane = tid & 63, wave = __builtin_amdgcn_readfirstlane(tid >> 6);
    const int G = gridDim.x; const int bx = blockIdx.x;
    const int vcu = (G % 8 == 0) ? (bx % 8) * (G / 8) + bx / 8 : bx;
    const int gw = vcu * NWAVES + wave, NGW = G * NWAVES;
    unsigned char* ws = argp()->ws;
    gu32* ctl = (gu32*)(ws + WS_CTL);
    const float* x = argp()->in[0]; float* out = argp()->out;
    bf16* AB = (bf16*)(ws + WS_AB); bf16* P0 = (bf16*)(ws + WS_P0); bf16* P1 = (bf16*)(ws + WS_P1); bf16* P2 = (bf16*)(ws + WS_P2);
    bf16* ACT = (bf16*)(ws + WS_ACT); bf16* OB = (bf16*)(ws + WS_OB); float* ROPE = (float*)(ws + WS_ROPE);
    for (int u = tid; u < (LDS_BYTES - LDSCTL_OFF) / 4; u += NWAVES * 64) ((LAS unsigned*)(lds + LDSCTL_OFF))[u] = 0u;
    __syncthreads();
    for (unsigned u = (unsigned)(bx * NWAVES * 64 + tid); u < CTL_ZERO_BYTES / 4; u += (unsigned)(G * NWAVES * 64)) ctl[u] = 0u;


    {
        LAS float* scr = (LAS float*)(lds + wave * 16384);
        constexpr int I_QKV = 32 * 192, I_O = 32 * 64, I_GU = 32 * 352, I_D = 88 * 64, I_KV = 32 * 128;
        constexpr int NITEMS = I_QKV + 3 * I_O + 2 * I_GU + 2 * I_D + I_KV;
        for (int it = gw; it < NITEMS; it += NGW) {
            int r = it;
            if (r < I_QKV) { transpose_item(argp()->in[2], D, NPROJ, (bf16*)(ws + WS_WQKV_A), 0, 0, argp()->in[1], scr, r, lane); continue; } r -= I_QKV;
            if (r < I_O)   { transpose_item(argp()->in[3], D, D, (bf16*)(ws + WS_WO_A), 0, 0, nullptr, scr, r, lane); continue; } r -= I_O;
            if (r < I_GU)  { transpose_item(argp()->in[5], D, 2 * FF, (bf16*)(ws + WS_WGU_A), 0, 1, argp()->in[4], scr, r, lane); continue; } r -= I_GU;
            if (r < I_D)   { transpose_item(argp()->in[6], FF, D, (bf16*)(ws + WS_WD_A), 0, 0, nullptr, scr, r, lane); continue; } r -= I_D;
            if (r < I_KV)  { transpose_item(argp()->in[8], D, 2 * D, (bf16*)(ws + WS_WKVQ), 0, 0, argp()->in[7], scr, r, lane); continue; } r -= I_KV;
            if (r < I_O)   { transpose_item(argp()->in[11], D, D, (bf16*)(ws + WS_WKVQ), 2 * D, 0, argp()->in[10], scr, r, lane); continue; } r -= I_O;
            if (r < I_O)   { transpose_item(argp()->in[18], D, D, (bf16*)(ws + WS_WO_B), 0, 0, nullptr, scr, r, lane); continue; } r -= I_O;
            if (r < I_GU)  { if (G != 256) transpose_item(argp()->in[20], D, 2 * FF, (bf16*)(ws + WS_WGU_B), 0, 1, argp()->in[19], scr, r, lane); continue; } r -= I_GU;
            if (G != 256) transpose_item(argp()->in[21], FF, D, (bf16*)(ws + WS_WD_B), 0, 0, nullptr, scr, r, lane);
        }
        xb_rows(x, (bf16*)(ws + WS_XB), (unsigned long long*)(ws + WS_SS) + 3 * (size_t)M, gw, NGW, lane);
        for (int e = (vcu * NWAVES * 64 + tid); e < SEQ * 64; e += G * NWAVES * 64) {
            const int pos = e >> 6, i = e & 63;
            const float inv_freq = powf(10000.0f, -(float)i * (1.0f / 64.0f));
            const float ang = (float)pos * inv_freq;
            const double rev = (double)ang * 0.15915494309189535;
            const float fr = (float)(rev - __builtin_rint(rev));
            ROPE[2 * e] = __builtin_amdgcn_cosf(fr); ROPE[2 * e + 1] = __builtin_amdgcn_sinf(fr);
        }
    }
    cg::this_grid().sync();
    (void)xcd_barrier_post((unsigned*)(ctl + CW_BAR), MISC + 8);

    layer_body<0>(lds, ws, x, out, G, bx, vcu, gw, NGW);
    layer_body<1>(lds, ws, x, out, G, bx, vcu, gw, NGW);
}

extern "C" void kernel_launch(void* const* d_in, const int* in_sizes, int n_in, void* d_out, int out_size, void* d_ws, size_t ws_size, hipStream_t stream) {
    static int grid = 0;
    if (grid == 0) {
        if (n_in != 22 || in_sizes[0] != M * D || out_size != M * D || ws_size < WS_END) { fprintf(stderr, "kernel_launch: unexpected problem shape / workspace (n_in %d, in0 %d, out %d, ws %zu)\n", n_in, n_in > 0 ? in_sizes[0] : -1, out_size, ws_size); grid = -1; return; }
        int dev = 0, cus = 0, per_cu = 0;
        if (hipGetDevice(&dev) != hipSuccess || hipDeviceGetAttribute(&cus, hipDeviceAttributeMultiprocessorCount, dev) != hipSuccess) { grid = -1; return; }
        if (hipFuncSetAttribute((const void*)fwd_megakernel, hipFuncAttributeMaxDynamicSharedMemorySize, LDS_BYTES) != hipSuccess) { fprintf(stderr, "kernel_launch: hipFuncSetAttribute failed\n"); grid = -1; return; }
        if (hipOccupancyMaxActiveBlocksPerMultiprocessor(&per_cu, (const void*)fwd_megakernel, NWAVES * 64, LDS_BYTES) != hipSuccess || per_cu < 1) { fprintf(stderr, "kernel_launch: occupancy query says %d blocks per CU\n", per_cu); (void)hipGetLastError(); per_cu = 1; }
        grid = cus;
    }
    if (grid < 0) return;
    Args a{};
    for (int i = 0; i < 22; ++i) a.in[i] = (const float*)d_in[i];
    a.out = (float*)d_out; a.ws = (unsigned char*)d_ws;
    void* kargs[] = {&a};
    const hipError_t e = hipLaunchCooperativeKernel((const void*)fwd_megakernel, dim3(grid), dim3(NWAVES * 64), kargs, LDS_BYTES, stream);
    if (e != hipSuccess) fprintf(stderr, "kernel_launch: cooperative launch failed: %s (grid %d)\n", hipGetErrorString(e), grid);
}
```

```cpp
#include <hip/hip_runtime.h>
#include <hip/hip_cooperative_groups.h>
#include <cstdio>
#include <cstdint>
#include <cmath>
namespace cg = cooperative_groups;
namespace pg8 {
#define PG8_LAS __attribute__((address_space(3)))
typedef unsigned short bf16_t;
typedef short bf16x8 __attribute__((ext_vector_type(8)));
typedef float f32x4 __attribute__((ext_vector_type(4)));
typedef unsigned u32x4 __attribute__((ext_vector_type(4)));
constexpr int BM = 256, BK = 64, HALF = 128, HTB = HALF * BK * 2  , STAGE_BYTES = 8 * HTB, NXCD = 8, WGM = 8;

__host__ __device__ __forceinline__ int lds_byte(int r, int c) { const int st = (r >> 4) * 2 + (c >> 5), rr = r & 15, cc = c & 31, ob = rr * 64 + cc * 2; return st * 1024 + (ob ^ (((ob >> 9) & 1) << 5)); }
__host__ __device__ __forceinline__ void stage_rc(int b, int& R, int& C) { const int st = b / 1024, sb = b % 1024, swz = sb ^ (((sb >> 9) & 1) << 5); R = (st >> 1) * 16 + swz / 64; C = (st & 1) * 32 + (swz % 64) / 2; }
__host__ __device__ __forceinline__ int perm32(int rho) { const int n = rho >> 4, i = rho & 15; return 8 * (i >> 2) + 4 * n + (i & 3); }

struct Unit { int pm, pn; };
struct Gemm { const bf16_t* A; const bf16_t* Bt; int M, N, K; };

struct StaticOrder {
    int nM, nN, nwg, G, c;
    __host__ __device__ void init(int M, int N, int G_, int c_) { nM = M / BM; nN = N / BM; nwg = nM * nN; G = G_; c = c_; }
    __host__ __device__ bool next(int i, Unit& u) const {
        const long L = (long)i * G + c; if (L >= nwg) return false;
        int wgid = (int)L; { const int q = nwg / NXCD, r = nwg % NXCD, xcd = wgid % NXCD, off = wgid / NXCD; wgid = (xcd < r ? xcd * (q + 1) : r * (q + 1) + (xcd - r) * q) + off; }
        const int nig = WGM * nN, gid = wgid / nig, fm = gid * WGM, gsz = (nM - fm) < WGM ? (nM - fm) : WGM;
        u.pm = fm + ((wgid % nig) % gsz); u.pn = (wgid % nig) / gsz; return true;
    }
    __device__ __forceinline__ void a_ready(const Unit&) const {}
    __device__ __forceinline__ void done(const Unit&) const {}
};

__device__ __forceinline__ unsigned cvt_pk_bf16(float lo, float hi) { unsigned r; asm volatile("v_cvt_pk_bf16_f32 %0, %1, %2" : "=v"(r) : "v"(lo), "v"(hi)); return r; }
typedef float f32x2 __attribute__((ext_vector_type(2)));
__device__ __forceinline__ f32x2 gelu_pk(f32x2 v) {
    const f32x2 av = __builtin_elementwise_abs(v), d = av * 0.2316418882f + 1.0f;
    f32x2 t; t.x = __builtin_amdgcn_rcpf(d.x); t.y = __builtin_amdgcn_rcpf(d.y);
    f32x2 q = t * 0.5307027145f + (-0.7265760135f); q = q * t + 0.7107068705f; q = q * t + (-0.142248368f); q = q * t + 0.127414796f; q = q * t;
    const f32x2 s = (v * v) * (-0.72134752044f);
    f32x2 e; e.x = __builtin_amdgcn_exp2f(s.x); e.y = __builtin_amdgcn_exp2f(s.y);
    const f32x2 m = v * (q * e), r = v - m;
    f32x2 o; o.x = v.x < 0.f ? m.x : r.x; o.y = v.y < 0.f ? m.y : r.y; return o;
}

template <int ACT  > struct EpiBf16 {
    static constexpr bool PERM = true, AFTER_DRAIN = false; static_assert(ACT == 0 || ACT == 1, "EpiBf16: ACT is 0 (none) or 1 (gelu_pk)");
    bf16_t* O; int ldc; const float* bias; int split_cols; size_t split_stride; float scale0;
    __device__ __forceinline__ void operator()(const f32x4 (&acc)[2][2][4][2], const Unit& u, int wr, int wc, int fr, int fq) const {
        const int row0 = u.pm * BM + wr * 64 + fr; int colt = u.pn * BM; bf16_t* base = O;
        float sc = 1.f; if (split_cols) { const int t = colt / split_cols; base += (size_t)t * split_stride; colt -= t * split_cols; if (t == 0) sc = scale0; }
        const int col0 = colt + wc * 32 + 8 * fq, bcol0 = u.pn * BM + wc * 32 + 8 * fq;
        f32x4 bv[2][2];
#pragma unroll
        for (int bj = 0; bj < 2; ++bj)
#pragma unroll
            for (int n = 0; n < 2; ++n) bv[bj][n] = bias ? *(const f32x4*)(bias + bcol0 + bj * HALF + 4 * n) : (f32x4){0.f, 0.f, 0.f, 0.f};
#pragma unroll
        for (int ai = 0; ai < 2; ++ai)
#pragma unroll
            for (int m = 0; m < 4; ++m) { bf16_t* rowp = base + (size_t)(row0 + ai * HALF + m * 16) * ldc + col0;
#pragma unroll
                for (int bj = 0; bj < 2; ++bj) { f32x4 v0 = acc[ai][bj][m][0] + bv[bj][0], v1 = acc[ai][bj][m][1] + bv[bj][1];
                    if (ACT == 1) { f32x2 a = gelu_pk((f32x2){v0[0], v0[1]}), b = gelu_pk((f32x2){v0[2], v0[3]}), c = gelu_pk((f32x2){v1[0], v1[1]}), d = gelu_pk((f32x2){v1[2], v1[3]});
                        v0 = (f32x4){a.x, a.y, b.x, b.y}; v1 = (f32x4){c.x, c.y, d.x, d.y}; }
                    v0 = v0 * sc; v1 = v1 * sc; u32x4 w; w.x = cvt_pk_bf16(v0[0], v0[1]); w.y = cvt_pk_bf16(v0[2], v0[3]); w.z = cvt_pk_bf16(v1[0], v1[1]); w.w = cvt_pk_bf16(v1[2], v1[3]);
                    *(u32x4*)(rowp + bj * HALF) = w; } }
    }
};
struct EpiRes {
    static constexpr bool PERM = false, AFTER_DRAIN = false;
    const float* base; float* out; int ldc;
    __device__ __forceinline__ void operator()(const f32x4 (&acc)[2][2][4][2], const Unit& u, int wr, int wc, int fr, int fq) const {
        const int row0 = u.pm * BM + wr * 64 + fr, col0 = u.pn * BM + wc * 32 + 4 * fq;
#pragma unroll
        for (int ai = 0; ai < 2; ++ai)
#pragma unroll
            for (int m = 0; m < 4; ++m) { const size_t off = (size_t)(row0 + ai * HALF + m * 16) * ldc + col0;
#pragma unroll
                for (int bj = 0; bj < 2; ++bj)
#pragma unroll
                    for (int n = 0; n < 2; ++n) { const f32x4 b = *(const f32x4*)(base + off + bj * HALF + n * 16); *(f32x4*)(out + off + bj * HALF + n * 16) = b + acc[ai][bj][m][n]; }  asm volatile("" ::: "memory"); }
    }
};
__device__ __forceinline__ float u64_to_f32(unsigned long long v) { return __builtin_fmaf((float)(unsigned)(v >> 32), 4294967296.0f, (float)(unsigned)v); }
struct EpiSwiglu {
    static constexpr bool PERM = true, AFTER_DRAIN = false;
    bf16_t* O; int ldo; const unsigned long long* ss; float inv_d, eps;
    static __device__ __forceinline__ float sg(float g, float u) { return g * u * __builtin_amdgcn_rcpf(1.0f + __builtin_amdgcn_exp2f(-1.4426950408889634f * g)); }
    __device__ __forceinline__ void operator()(const f32x4 (&acc)[2][2][4][2], const Unit& u, int wr, int wc, int fr, int fq) const {
        const int row0 = u.pm * BM + wr * 64 + fr, col0 = u.pn * HALF + wc * 32 + 8 * fq;
#pragma unroll
        for (int ai = 0; ai < 2; ++ai)
#pragma unroll
            for (int m = 0; m < 4; ++m) { const int row = row0 + ai * HALF + m * 16; bf16_t* rowp = O + (size_t)row * ldo + col0;
                const float r = __builtin_amdgcn_rsqf(u64_to_f32(ss[row]) * inv_d + eps);
                const float a = -1.4426950408889634f * r, r2 = r * r;
                f32x4 o4[2];
#pragma unroll
                for (int n = 0; n < 2; ++n) { const f32x4 g = acc[ai][0][m][n], uu = acc[ai][1][m][n]; const f32x4 t = g * a;
                    f32x4 d; d[0] = __builtin_amdgcn_exp2f(t[0]); d[1] = __builtin_amdgcn_exp2f(t[1]); d[2] = __builtin_amdgcn_exp2f(t[2]); d[3] = __builtin_amdgcn_exp2f(t[3]);
                    d = d + 1.0f;
                    f32x4 iv; iv[0] = __builtin_amdgcn_rcpf(d[0]); iv[1] = __builtin_amdgcn_rcpf(d[1]); iv[2] = __builtin_amdgcn_rcpf(d[2]); iv[3] = __builtin_amdgcn_rcpf(d[3]);
                    o4[n] = (g * uu) * (iv * r2); }
                u32x4 w; w.x = cvt_pk_bf16(o4[0][0], o4[0][1]); w.y = cvt_pk_bf16(o4[0][2], o4[0][3]); w.z = cvt_pk_bf16(o4[1][0], o4[1][1]); w.w = cvt_pk_bf16(o4[1][2], o4[1][3]);
                *(u32x4*)rowp = w; }
    }
};


struct EpiResNorm {
    static constexpr bool PERM = false, AFTER_DRAIN = false;
    const float* base; float* out; bf16_t* xb; float* ss; int ldc;
    __device__ __forceinline__ void operator()(const f32x4 (&acc)[2][2][4][2], const Unit& u, int wr, int wc, int fr, int fq) const {
        const int row0 = u.pm * BM + wr * 64 + fr, col0 = u.pn * BM + wc * 32 + 4 * fq;
#pragma unroll
        for (int ai = 0; ai < 2; ++ai)
#pragma unroll
            for (int m = 0; m < 4; ++m) { const int row = row0 + ai * HALF + m * 16; const size_t off = (size_t)row * ldc + col0; float s = 0.f;
#pragma unroll
                for (int bj = 0; bj < 2; ++bj)
#pragma unroll
                    for (int n = 0; n < 2; ++n) { const f32x4 b = *(const f32x4*)(base + off + bj * HALF + n * 16); const f32x4 v = b + acc[ai][bj][m][n]; *(f32x4*)(out + off + bj * HALF + n * 16) = v;
                        s += (v[0] * v[0] + v[1] * v[1]) + (v[2] * v[2] + v[3] * v[3]);
                        unsigned long long w = (unsigned long long)cvt_pk_bf16(v[0], v[1]) | ((unsigned long long)cvt_pk_bf16(v[2], v[3]) << 32);
                        *(unsigned long long*)(xb + off + bj * HALF + n * 16) = w; }
                s += __shfl_xor(s, 16); s += __shfl_xor(s, 32);
                if (fq == 0) atomicAdd(ss + row, s);
                asm volatile("" ::: "memory"); }
    }
};
struct EpiProj {
    static constexpr bool PERM = true, AFTER_DRAIN = false;
    bf16_t* O; int ldc; int split_cols; size_t split_stride; float scale0; const unsigned long long* ss; float inv_d, eps;
    __device__ __forceinline__ void operator()(const f32x4 (&acc)[2][2][4][2], const Unit& u, int wr, int wc, int fr, int fq) const {
        const int row0 = u.pm * BM + wr * 64 + fr; int colt = u.pn * BM; bf16_t* base = O;
        float sc = 1.f; { const int t = colt / split_cols; base += (size_t)t * split_stride; colt -= t * split_cols; if (t == 0) sc = scale0; }
        const int col0 = colt + wc * 32 + 8 * fq;
#pragma unroll
        for (int ai = 0; ai < 2; ++ai)
#pragma unroll
            for (int m = 0; m < 4; ++m) { const int row = row0 + ai * HALF + m * 16; bf16_t* rowp = base + (size_t)row * ldc + col0;
                const float r = ss ? sc * __builtin_amdgcn_rsqf(u64_to_f32(ss[row]) * inv_d + eps) : sc;
#pragma unroll
                for (int bj = 0; bj < 2; ++bj) { const f32x4 v0 = acc[ai][bj][m][0] * r, v1 = acc[ai][bj][m][1] * r;
                    u32x4 w; w.x = cvt_pk_bf16(v0[0], v0[1]); w.y = cvt_pk_bf16(v0[2], v0[3]); w.z = cvt_pk_bf16(v1[0], v1[1]); w.w = cvt_pk_bf16(v1[2], v1[3]);
                    *(u32x4*)(rowp + bj * HALF) = w; } }
    }
};

template <bool BASE_BF16, bool OUT_F32, bool WRITE_XB> struct EpiRes2 {
    static constexpr bool PERM = false, AFTER_DRAIN = false;
    const void* base; float* out; bf16_t* xb; unsigned long long* ss; int ldc;
    __device__ __forceinline__ void operator()(const f32x4 (&acc)[2][2][4][2], const Unit& u, int wr, int wc, int fr, int fq) const {
        const int row0 = u.pm * BM + wr * 64 + fr, col0 = u.pn * BM + wc * 32 + 4 * fq;
#pragma unroll
        for (int ai = 0; ai < 2; ++ai)
#pragma unroll
            for (int m = 0; m < 4; ++m) { const int row = row0 + ai * HALF + m * 16; const size_t off = (size_t)row * ldc + col0; float s = 0.f;
#pragma unroll
                for (int bj = 0; bj < 2; ++bj)
#pragma unroll
                    for (int n = 0; n < 2; ++n) { const size_t o2 = off + bj * HALF + n * 16; f32x4 b;
                        if (BASE_BF16) { const unsigned long long w = *(const unsigned long long*)((const bf16_t*)base + o2);
                            b = (f32x4){__uint_as_float((unsigned)w << 16), __uint_as_float((unsigned)w & 0xffff0000u), __uint_as_float((unsigned)(w >> 32) << 16), __uint_as_float((unsigned)(w >> 32) & 0xffff0000u)}; }
                        else b = *(const f32x4*)((const float*)base + o2);
                        const f32x4 v = b + acc[ai][bj][m][n];
                        if (OUT_F32) *(f32x4*)(out + o2) = v;
                        s += (v[0] * v[0] + v[1] * v[1]) + (v[2] * v[2] + v[3] * v[3]);
                        if (WRITE_XB) *(unsigned long long*)(xb + o2) = (unsigned long long)cvt_pk_bf16(v[0], v[1]) | ((unsigned long long)cvt_pk_bf16(v[2], v[3]) << 32); }
                if (ss) { s += __shfl_xor(s, 16); s += __shfl_xor(s, 32); if (fq == 0) atomicAdd(ss + row, (unsigned long long)(s * 16777216.0f)); }
                asm volatile("" ::: "memory"); }
    }
};
template <class Epi, class Sched, bool ALIGN_EPI = false, bool SP2 = false>
__device__ __forceinline__ void gemm_phase(PG8_LAS unsigned char* lds, const Gemm g, const Sched& S, const Epi& E) {
    int tid_ = threadIdx.x; asm volatile("" : "+v"(tid_));
    const int tid = tid_, wid = __builtin_amdgcn_readfirstlane(tid >> 6), lane = tid & 63, wr = wid >> 2, wc = wid & 3, fr = lane & 15, fq = lane >> 4;
    const int K = g.K, nt = K / BK;
    unsigned voffA[2], voffB[2];
#pragma unroll
    for (int i = 0; i < 2; ++i) { int R, C; stage_rc(tid * 16 + i * 8192, R, C); const int Rb = Epi::PERM ? ((R & ~31) + perm32(R & 31)) : R;
        voffA[i] = (unsigned)(R * K + C) * 2u; voffB[i] = (unsigned)(Rb * K + C) * 2u; }
    const size_t kstep = (size_t)(BK * 2);
    const size_t hstep = (size_t)HALF * K * 2;
    const size_t tstep = 2 * hstep;
    const unsigned ldsw = (unsigned)wid * 1024u;
    const int aoff = lds_byte(wr * 64 + fr, fq * 8), boff = lds_byte(wc * 32 + fr, fq * 8);
#define PG8_SA(b, h) (((b) * 2 + (h)) * HTB)
#define PG8_SB(b, h) ((4 + (b) * 2 + (h)) * HTB)
#define PG8_STAGE(bufoff, gbase, voff) do { _Pragma("unroll") for (int _i = 0; _i < 2; ++_i) \
        __builtin_amdgcn_global_load_lds((const unsigned*)((const char*)(gbase) + (voff)[_i]), (PG8_LAS unsigned*)(lds + (bufoff) + ldsw + _i * 8192), 16, 0, 0); } while (0)
#define PG8_LDA(dst, b, h) do { _Pragma("unroll") for (int m = 0; m < 4; ++m) _Pragma("unroll") for (int k = 0; k < 2; ++k) dst[m][k] = *(const PG8_LAS bf16x8*)(lds + PG8_SA(b, h) + aoff + m * 2048 + k * 1024); } while (0)
#define PG8_LDB(dst, b, h) do { _Pragma("unroll") for (int n = 0; n < 2; ++n) _Pragma("unroll") for (int k = 0; k < 2; ++k) dst[n][k] = *(const PG8_LAS bf16x8*)(lds + PG8_SB(b, h) + boff + n * 2048 + k * 1024); } while (0)
#define PG8_MMA(ai, bj, At, Bt) do { __builtin_amdgcn_s_setprio(1); _Pragma("unroll") for (int m = 0; m < 4; ++m) _Pragma("unroll") for (int n = 0; n < 2; ++n) _Pragma("unroll") for (int k = 0; k < 2; ++k) \
        acc[ai][bj][m][n] = __builtin_amdgcn_mfma_f32_16x16x32_bf16(Bt[n][k], At[m][k], acc[ai][bj][m][n], 0, 0, 0); __builtin_amdgcn_s_setprio(0); } while (0)
#define PG8_WAIT_V(n) asm volatile("s_waitcnt vmcnt(" #n ")" ::: "memory")
#define PG8_WAIT_L(n) asm volatile("s_waitcnt lgkmcnt(" #n ")" ::: "memory")
#define PG8_BAR __builtin_amdgcn_s_barrier()
#define PG8_SCHED __builtin_amdgcn_sched_barrier(0)
    Unit cur, nxt; int ui = 0;
    if (!S.next(0, cur)) return;
    f32x4 acc[2][2][4][2];
#pragma unroll
    for (int a = 0; a < 2; ++a)
#pragma unroll
        for (int b = 0; b < 2; ++b)
#pragma unroll
            for (int m = 0; m < 4; ++m)
#pragma unroll
                for (int n = 0; n < 2; ++n) acc[a][b][m][n] = (f32x4){0.f, 0.f, 0.f, 0.f};
    bf16x8 At[4][2], B0[2][2], B1[2][2];
    const char* cA = (const char*)g.A + (size_t)cur.pm * tstep; const char* cB = (const char*)g.Bt + (size_t)cur.pn * tstep;
    S.a_ready(cur);
    if constexpr (SP2) {
        PG8_STAGE(PG8_SB(0, 0), cB, voffB); PG8_STAGE(PG8_SB(0, 1), cB + hstep, voffB); PG8_STAGE(PG8_SA(0, 0), cA, voffA); PG8_STAGE(PG8_SA(0, 1), cA + hstep, voffA);
        if (wr == 1) PG8_BAR;
        PG8_WAIT_V(2); PG8_BAR;
        PG8_STAGE(PG8_SB(1, 0), cB + kstep, voffB); PG8_STAGE(PG8_SA(1, 0), cA + kstep, voffA); PG8_STAGE(PG8_SB(1, 1), cB + hstep + kstep, voffB);
        PG8_WAIT_V(6); PG8_BAR;
    } else {
        PG8_STAGE(PG8_SB(0, 0), cB, voffB); PG8_STAGE(PG8_SA(0, 0), cA, voffA); PG8_STAGE(PG8_SB(0, 1), cB + hstep, voffB); PG8_STAGE(PG8_SA(0, 1), cA + hstep, voffA);
        if (wr == 1) PG8_BAR;
        PG8_WAIT_V(4); PG8_BAR;
        PG8_STAGE(PG8_SB(1, 0), cB + kstep, voffB); PG8_STAGE(PG8_SA(1, 0), cA + kstep, voffA); PG8_STAGE(PG8_SB(1, 1), cB + hstep + kstep, voffB);
        PG8_WAIT_V(6); PG8_BAR;
    }
    for (;;) {
        const bool has_next = S.next(ui + 1, nxt);
        const char* nA = has_next ? (const char*)g.A + (size_t)nxt.pm * tstep : cA; const char* nB = has_next ? (const char*)g.Bt + (size_t)nxt.pn * tstep : cB;
        for (int t = 0; t < nt; t += 2) {
            const bool last = (t == nt - 2);
            const char* a1 = cA + (size_t)(t + 1) * kstep;
            const char* a2 = last ? nA : cA + (size_t)(t + 2) * kstep; const char* b2 = last ? nB : cB + (size_t)(t + 2) * kstep;
            const char* a3 = a2 + kstep; const char* b3 = b2 + kstep;
            if (last && has_next) S.a_ready(nxt);
            if constexpr (SP2) {
            PG8_LDB(B0, 0, 0); PG8_LDB(B1, 0, 1); PG8_SCHED; PG8_LDA(At, 0, 0); PG8_STAGE(PG8_SA(1, 1), a1 + hstep, voffA);
            PG8_WAIT_V(8); PG8_WAIT_L(0); PG8_BAR; PG8_MMA(0, 0, At, B0); PG8_MMA(0, 1, At, B1); PG8_BAR; PG8_SCHED;
            PG8_LDA(At, 0, 1); PG8_STAGE(PG8_SB(0, 0), b2, voffB); PG8_STAGE(PG8_SB(0, 1), b2 + hstep, voffB); PG8_STAGE(PG8_SA(0, 0), a2, voffA);
            PG8_WAIT_V(8); PG8_WAIT_L(0); PG8_BAR; PG8_MMA(1, 0, At, B0); PG8_MMA(1, 1, At, B1); PG8_BAR; PG8_SCHED;
            PG8_LDB(B0, 1, 0); PG8_LDB(B1, 1, 1); PG8_SCHED; PG8_LDA(At, 1, 0); PG8_STAGE(PG8_SA(0, 1), a2 + hstep, voffA);
            PG8_WAIT_V(8); PG8_WAIT_L(0); PG8_BAR; PG8_MMA(0, 0, At, B0); PG8_MMA(0, 1, At, B1); PG8_BAR; PG8_SCHED;
            PG8_LDA(At, 1, 1); PG8_STAGE(PG8_SB(1, 0), b3, voffB); PG8_STAGE(PG8_SB(1, 1), b3 + hstep, voffB); PG8_STAGE(PG8_SA(1, 0), a3, voffA);
            PG8_WAIT_V(8); PG8_WAIT_L(0); PG8_BAR; PG8_MMA(1, 0, At, B0); PG8_MMA(1, 1, At, B1); PG8_BAR; PG8_SCHED;
            } else {
            PG8_LDB(B0, 0, 0); PG8_SCHED; PG8_LDA(At, 0, 0); PG8_STAGE(PG8_SA(1, 1), a1 + hstep, voffA);
            PG8_WAIT_L(8); PG8_BAR; PG8_WAIT_L(0); PG8_MMA(0, 0, At, B0); PG8_BAR; PG8_SCHED;
            PG8_LDB(B1, 0, 1); PG8_STAGE(PG8_SB(0, 0), b2, voffB);
            PG8_BAR; PG8_WAIT_L(0); PG8_MMA(0, 1, At, B1); PG8_BAR;
            PG8_LDA(At, 0, 1); PG8_STAGE(PG8_SA(0, 0), a2, voffA);
            PG8_BAR; PG8_WAIT_L(0); PG8_MMA(1, 0, At, B0); PG8_BAR; PG8_SCHED;
            PG8_STAGE(PG8_SB(0, 1), b2 + hstep, voffB);
            PG8_WAIT_V(6); PG8_BAR; PG8_MMA(1, 1, At, B1); PG8_BAR;
            PG8_LDB(B0, 1, 0); PG8_SCHED; PG8_LDA(At, 1, 0); PG8_STAGE(PG8_SA(0, 1), a2 + hstep, voffA);
            PG8_WAIT_L(8); PG8_BAR; PG8_WAIT_L(0); PG8_MMA(0, 0, At, B0); PG8_BAR; PG8_SCHED;
            PG8_LDB(B1, 1, 1); PG8_STAGE(PG8_SB(1, 0), b3, voffB);
            PG8_BAR; PG8_WAIT_L(0); PG8_MMA(0, 1, At, B1); PG8_BAR;
            PG8_LDA(At, 1, 1); PG8_STAGE(PG8_SA(1, 0), a3, voffA);
            PG8_BAR; PG8_WAIT_L(0); PG8_MMA(1, 0, At, B0); PG8_BAR; PG8_SCHED;
            PG8_STAGE(PG8_SB(1, 1), b3 + hstep, voffB);
            PG8_WAIT_V(6); PG8_BAR; PG8_MMA(1, 1, At, B1); PG8_BAR;
            }
        }
        if constexpr (ALIGN_EPI) { if (wr == 0) PG8_BAR; }
        if constexpr (!Epi::AFTER_DRAIN) { E(acc, cur, wr, wc, fr, fq); S.done(cur); }
        if (!has_next) break;
#pragma unroll
        for (int a = 0; a < 2; ++a)
#pragma unroll
            for (int b = 0; b < 2; ++b)
#pragma unroll
                for (int m = 0; m < 4; ++m)
#pragma unroll
                    for (int n = 0; n < 2; ++n) acc[a][b][m][n] = (f32x4){0.f, 0.f, 0.f, 0.f};
        cur = nxt; cA = nA; cB = nB; ++ui;
        if constexpr (ALIGN_EPI) { if (wr == 1) PG8_BAR; }
    }
    PG8_WAIT_V(0);
    if constexpr (!ALIGN_EPI) { if (wr == 0) PG8_BAR; }
    PG8_BAR;
    if constexpr (Epi::AFTER_DRAIN) { E.fused(acc, cur, wr, wc, fr, fq, lds, wid, lane); S.done(cur); }
#undef PG8_SA
#undef PG8_SB
#undef PG8_STAGE
#undef PG8_LDA
#undef PG8_LDB
#undef PG8_MMA
#undef PG8_WAIT_V
#undef PG8_WAIT_L
#undef PG8_BAR
#undef PG8_SCHED
}
}
namespace att {
#define ATT_LAS __attribute__((address_space(3)))
typedef unsigned short bf16_t;
typedef short bf16x8 __attribute__((ext_vector_type(8)));
typedef short s16x4 __attribute__((ext_vector_type(4)));
typedef short v4i16_t __attribute__((ext_vector_type(4)));
typedef float f32x16 __attribute__((ext_vector_type(16)));
typedef float f32x4 __attribute__((ext_vector_type(4)));
typedef unsigned u32x4 __attribute__((ext_vector_type(4)));
typedef float f32x2_t __attribute__((ext_vector_type(2)));
typedef __bf16 bf16x2_t __attribute__((ext_vector_type(2)));
constexpr int SEQ = 4096, PITCH = 2048, QB = 256, KVB = 64, TILE_BYTES = 16384;
constexpr int LDS_K = 0, LDS_V = 2 * TILE_BYTES, LDS_WS = 131072 + 2048, LDS_FLAG = LDS_WS + 8 * 256, LDS_BYTES = LDS_FLAG + 64;
constexpr float SB_DONE = -160.0f;
__device__ __forceinline__ unsigned off_b(unsigned row, unsigned ch) { return 256u * row + 16u * (ch ^ (((row & 3u) << 2) | ((row >> 2) & 3u))); }
__device__ __forceinline__ unsigned cvtpk(float lo, float hi) { f32x2_t v = {lo, hi}; bf16x2_t b = __builtin_convertvector(v, bf16x2_t); return __builtin_bit_cast(unsigned, b); }
__device__ __forceinline__ s16x4 vtr(const ATT_LAS unsigned char* p) { return __builtin_bit_cast(s16x4, __builtin_amdgcn_ds_read_tr16_b64_v4i16((ATT_LAS v4i16_t*)p)); }
#define ATT_MFMA(a, b, c) __builtin_amdgcn_mfma_f32_32x32x16_bf16((a), (b), (c), 0, 0, 0)

__device__ __forceinline__ const float* att_qgain();
__device__ __forceinline__ const float* att_rope();
template <int MODE, int NC, bool QROPE = false>
__device__ __forceinline__ void attn_unit(ATT_LAS unsigned char* lds, const bf16_t* __restrict__ Qp, const bf16_t* __restrict__ Kp, const bf16_t* __restrict__ Vp, void* Op, int q0) {
  int tid_ = threadIdx.x; asm volatile("" : "+v"(tid_));
  const int tid = tid_, lane = tid & 63, r32 = lane & 31, hi = lane >> 5;
  const int wid = __builtin_amdgcn_readfirstlane(tid >> 6);
  const int qrow0 = q0 + 32 * wid, t = qrow0 + r32;
  const int NT = (q0 + QB) / KVB;
  bf16x8 qf[8];
#pragma unroll
  for (int s = 0; s < 8; ++s) qf[s] = *(const bf16x8*)(Qp + (size_t)t * PITCH + 16 * s + 8 * hi);
  if (QROPE) {
    const float* __restrict__ qgain = att_qgain(); const float* __restrict__ rope = att_rope(); constexpr float qscale = 0.08838834764831845f * 1.4426950408889634f;
    float ss = 0.f;
#pragma unroll
    for (int s = 0; s < 8; ++s)
#pragma unroll
      for (int e = 0; e < 8; ++e) { const float v = __uint_as_float(((unsigned)(unsigned short)qf[s][e]) << 16); ss += v * v; }
    ss += __shfl_xor(ss, 32);
    const float rr = 1.0f / sqrtf(ss * (1.0f / 128.0f) + 1e-6f);
    const float* cs = rope + (size_t)t * 128;
#pragma unroll
    for (int s = 0; s < 4; ++s) {
      u32x4 wa, wb;
#pragma unroll
      for (int e = 0; e < 8; e += 2) {
        float oa[2], ob[2];
#pragma unroll
        for (int h2 = 0; h2 < 2; ++h2) { const int i = 16 * s + 8 * hi + e + h2;
          const float xa = __uint_as_float(((unsigned)(unsigned short)qf[s][e + h2]) << 16), xb = __uint_as_float(((unsigned)(unsigned short)qf[s + 4][e + h2]) << 16);
          const float ya = xa * rr * qgain[i], yb = xb * rr * qgain[64 + i], co = cs[2 * i], si = cs[2 * i + 1];
          oa[h2] = (ya * co - yb * si) * qscale; ob[h2] = (yb * co + ya * si) * qscale; }
        wa[e >> 1] = cvtpk(oa[0], oa[1]); wb[e >> 1] = cvtpk(ob[0], ob[1]);
      }
      qf[s] = __builtin_bit_cast(bf16x8, wa); qf[s + 4] = __builtin_bit_cast(bf16x8, wb);
    }
  }
  constexpr int VBUF = (NC / 4) * TILE_BYTES;
#define ATT_DMA(jt_, kbuf_, vbuf_) do { const size_t go_ = (size_t)(KVB * (jt_)) * PITCH; unsigned l_ = (unsigned)lane; asm volatile("" : "+v"(l_)); unsigned kgl[2]; \
    _Pragma("unroll") for (int i2 = 0; i2 < 2; ++i2) { const unsigned pc = 2u * wid + i2, rr = 4u * pc + (l_ >> 4), ch = (l_ & 15u) ^ (((l_ >> 4) & 3u) << 2 | (pc & 3u)); kgl[i2] = rr * PITCH + 8u * ch; } \
    _Pragma("unroll") for (int i2 = 0; i2 < 2; ++i2) { \
      __builtin_amdgcn_global_load_lds((const unsigned*)(Kp + go_ + kgl[i2]), (ATT_LAS unsigned*)(lds + LDS_K + (kbuf_) * TILE_BYTES + wid * 2048 + i2 * 1024), 16, 0, 0); \
      _Pragma("unroll") for (int hf = 0; hf < NC / 4; ++hf) \
        __builtin_amdgcn_global_load_lds((const unsigned*)(Vp + go_ + 128 * hf + kgl[i2]), (ATT_LAS unsigned*)(lds + LDS_V + (vbuf_) * VBUF + hf * TILE_BYTES + wid * 2048 + i2 * 1024), 16, 0, 0); } } while (0)
  const unsigned kbase = 256u * (unsigned)r32, kx = 16u * ((unsigned)hi ^ ((((unsigned)r32 & 3u) << 2) | (((unsigned)r32 >> 2) & 3u)));
  const unsigned vq = ((unsigned)lane & 15u) >> 2;
  unsigned vbase[2];
  { const unsigned p = (unsigned)lane & 3u, blk = ((unsigned)lane >> 4) & 1u, low = 2u * blk + (p >> 1);
#pragma unroll
    for (int jj = 0; jj < 2; ++jj) vbase[jj] = 256u * (8u * jj + 4u * hi + vq) + 16u * (low ^ (2u * jj + hi)) + 8u * (p & 1u); }
  ATT_LAS float* wsf = (ATT_LAS float*)(lds + LDS_WS) + wid * 64;
  ATT_LAS unsigned* flags = (ATT_LAS unsigned*)(lds + LDS_FLAG);
  f32x16 o[NC];
#pragma unroll
  for (int c = 0; c < NC; ++c)
#pragma unroll
    for (int r = 0; r < 16; ++r) o[c][r] = 0.f;
  float m_run = -INFINITY, l_run = 0.f, carry = 0.f;
  bool wdone = false;
  const bool lag = wid >= 4;
  bool pend = false; unsigned pvb = 0u;
  u32x4 pk[4];
#pragma unroll
  for (int s4 = 0; s4 < 4; ++s4) pk[s4] = (u32x4){0u, 0u, 0u, 0u};
#define ATT_PV(VB_) do { const ATT_LAS unsigned char* vb = (VB_); __builtin_amdgcn_s_setprio(1); \
    _Pragma("unroll") for (int s4 = 0; s4 < 4; ++s4) { const bf16x8 pa = __builtin_bit_cast(bf16x8, pk[s4]); \
      _Pragma("unroll") for (int c = 0; c < NC; ++c) { const unsigned vo = 64u * ((unsigned)(c & 3) ^ vq) + (c >> 2) * TILE_BYTES + 4096 * s4; \
        const s16x4 lo = vtr(vb + vbase[0] + vo), hh = vtr(vb + vbase[1] + vo); \
        const bf16x8 vf = __builtin_shufflevector(lo, hh, 0, 1, 2, 3, 4, 5, 6, 7); \
        o[c] = ATT_MFMA(pa, vf, o[c]); } \
      if (NC == 8) __builtin_amdgcn_sched_barrier(0); } \
    __builtin_amdgcn_s_setprio(0); } while (0)
  ATT_DMA(MODE == 0 ? NT - 1 : 0, 0, 0);
  asm volatile("s_waitcnt vmcnt(0)" ::: "memory");
  __syncthreads();
  int vcur = 0;
  for (int i = 0; i < NT; ++i) {
    const int jt = MODE == 0 ? NT - 1 - i : i; const int buf = i & 1; const int kv0 = KVB * jt;
    const bool more = i + 1 < NT;
    const int vnext = vcur == 2 ? 0 : vcur + 1;
    if (more) ATT_DMA(MODE == 0 ? jt - 1 : jt + 1, buf ^ 1, vnext);
    if (lag && pend) { ATT_PV(lds + LDS_V + pvb); pend = false; }
    const bool active = MODE == 0 ? (kv0 < qrow0 + 31 && !wdone) : (kv0 <= qrow0 + 31);
    f32x16 p0, p1;
    if (active) {
      const ATT_LAS unsigned char* kb = lds + LDS_K + buf * TILE_BYTES;
#pragma unroll
      for (int r = 0; r < 16; ++r) { p0[r] = 0.f; p1[r] = 0.f; }
      __builtin_amdgcn_s_setprio(1);
#pragma unroll
      for (int s = 0; s < 8; ++s) {
        const unsigned ko = kbase + ((32u * s) ^ kx);
        const bf16x8 k0 = *(const ATT_LAS bf16x8*)(kb + ko);
        const bf16x8 k1 = *(const ATT_LAS bf16x8*)(kb + ko + 8192);
        p0 = ATT_MFMA(k0, qf[s], p0); p1 = ATT_MFMA(k1, qf[s], p1);
      }
      __builtin_amdgcn_s_setprio(0);
      if (MODE == 1) {
        const bool full = (kv0 + 63 <= qrow0);
        if (!full) {
#pragma unroll
          for (int r = 0; r < 16; ++r) { const int kv = kv0 + (r & 3) + 8 * (r >> 2) + 4 * hi; if (kv > t) p0[r] = -INFINITY; if (kv + 32 > t) p1[r] = -INFINITY; }
        }
        float mx = __builtin_fmaxf(__builtin_fmaxf(p0[0], p1[0]), __builtin_fmaxf(p0[1], p1[1]));
#pragma unroll
        for (int r = 2; r < 16; r += 2) mx = __builtin_fmaxf(__builtin_fmaxf(mx, __builtin_fmaxf(p0[r], p1[r])), __builtin_fmaxf(p0[r + 1], p1[r + 1]));
        mx = fmaxf(mx, __shfl_xor(mx, 32));
        float alpha = 1.0f;
        const bool upd = __builtin_amdgcn_ballot_w64(mx > m_run + 8.0f) != 0ull;
        if (upd) { const float m_new = fmaxf(m_run, mx); alpha = __builtin_amdgcn_exp2f(m_run - m_new); m_run = m_new; }
        float rs = 0.f;
#pragma unroll
        for (int r = 0; r < 16; ++r) { p0[r] = __builtin_amdgcn_exp2f(p0[r] - m_run); p1[r] = __builtin_amdgcn_exp2f(p1[r] - m_run); rs += p0[r] + p1[r]; }
        l_run = l_run * alpha + rs;
        if (upd) {
          if (hi == 0) wsf[r32] = alpha;
#pragma unroll
          for (int g = 0; g < 4; ++g) { const f32x4 a4 = *(const ATT_LAS f32x4*)(wsf + 8 * g + 4 * hi);
#pragma unroll
            for (int c = 0; c < NC; ++c)
#pragma unroll
              for (int e = 0; e < 4; ++e) o[c][4 * g + e] *= a4[e]; }
        }
      } else {
        const bool full = (kv0 + 63 < qrow0);
        float l1a[16], l1b[16];
#pragma unroll
        for (int r = 0; r < 16; ++r) {
          const int kv = kv0 + (r & 3) + 8 * (r >> 2) + 4 * hi;
          { const float z = p0[r]; const float e = __builtin_amdgcn_exp2f(-fabsf(z)); const float lg = __builtin_amdgcn_logf(1.0f + e);
            float v = -(fmaxf(z, 0.f) + lg); if (!full && !(kv < t)) v = 0.f; l1a[r] = v; }
          { const float z = p1[r]; const float e = __builtin_amdgcn_exp2f(-fabsf(z)); const float lg = __builtin_amdgcn_logf(1.0f + e);
            float v = -(fmaxf(z, 0.f) + lg); if (!full && !(kv + 32 < t)) v = 0.f; l1b[r] = v; }
        }
        float SM[9], SP[9]; SM[8] = 0.f; SP[8] = 0.f;
#pragma unroll
        for (int g = 3; g >= 0; --g) SM[4 + g] = ((l1b[4 * g] + l1b[4 * g + 1]) + (l1b[4 * g + 2] + l1b[4 * g + 3])) + SM[5 + g];
#pragma unroll
        for (int g = 3; g >= 0; --g) SM[g] = ((l1a[4 * g] + l1a[4 * g + 1]) + (l1a[4 * g + 2] + l1a[4 * g + 3])) + SM[1 + g];
#pragma unroll
        for (int i2 = 0; i2 < 8; ++i2) SP[i2] = __shfl_xor(SM[i2], 32);
#pragma unroll
        for (int i2 = 0; i2 < 8; ++i2) {
          float later = carry + SM[i2 + 1] + (hi ? SP[i2 + 1] : SP[i2]);
#pragma unroll
          for (int e = 3; e >= 0; --e) {
            const int r = 4 * (i2 & 3) + e; const int kv = kv0 + 32 * (i2 >> 2) + e + 8 * (i2 & 3) + 4 * hi;
            const float z = (i2 >> 2) ? p1[r] : p0[r]; const float l1 = (i2 >> 2) ? l1b[r] : l1a[r];
            float a = __builtin_amdgcn_exp2f(z + l1 + later); if (!full && !(kv < t)) a = 0.f;
            if (i2 >> 2) p1[r] = a; else p0[r] = a;
            later += l1;
          }
        }
        carry += SM[0] + SP[0];
        wdone = (__builtin_amdgcn_ballot_w64(carry >= SB_DONE) == 0ull);
      }
    }
    if (active) {
      pk[0] = (u32x4){cvtpk(p0[0], p0[1]), cvtpk(p0[2], p0[3]), cvtpk(p0[4], p0[5]), cvtpk(p0[6], p0[7])};
      pk[1] = (u32x4){cvtpk(p0[8], p0[9]), cvtpk(p0[10], p0[11]), cvtpk(p0[12], p0[13]), cvtpk(p0[14], p0[15])};
      pk[2] = (u32x4){cvtpk(p1[0], p1[1]), cvtpk(p1[2], p1[3]), cvtpk(p1[4], p1[5]), cvtpk(p1[6], p1[7])};
      pk[3] = (u32x4){cvtpk(p1[8], p1[9]), cvtpk(p1[10], p1[11]), cvtpk(p1[12], p1[13]), cvtpk(p1[14], p1[15])};
      if (lag) { pend = true; pvb = (unsigned)(vcur * VBUF); }
      else ATT_PV(lds + LDS_V + vcur * VBUF);
    }
    vcur = vnext;
    if (MODE == 0) { if (lane == 0) flags[(i & 1) * 8 + wid] = wdone ? 1u : 0u; }
    asm volatile("s_waitcnt vmcnt(0)" ::: "memory");
    __syncthreads();
    if (MODE == 0) {
      const u32x4 fa = *(const ATT_LAS u32x4*)(flags + (i & 1) * 8), fb = *(const ATT_LAS u32x4*)(flags + (i & 1) * 8 + 4);
      const unsigned all = fa[0] & fa[1] & fa[2] & fa[3] & fb[0] & fb[1] & fb[2] & fb[3];
      if (__builtin_amdgcn_readfirstlane(all) != 0u) break;
    }
  }
  if (lag && pend) ATT_PV(lds + LDS_V + pvb);
  if (MODE == 1) {
    const float l = l_run + __shfl_xor(l_run, 32);
    if (hi == 0) wsf[r32] = 1.0f / l;
    bf16_t* O = (bf16_t*)Op;
#pragma unroll
    for (int g = 0; g < 4; ++g) { const f32x4 i4 = *(const ATT_LAS f32x4*)(wsf + 8 * g + 4 * hi);
#pragma unroll
      for (int e = 0; e < 4; ++e) { bf16_t* orow = O + (size_t)(qrow0 + 8 * g + 4 * hi + e) * PITCH + r32;
#pragma unroll
        for (int c = 0; c < NC; ++c) orow[32 * c] = (bf16_t)(cvtpk(o[c][4 * g + e] * i4[e], 0.f) & 0xffffu); } }
  } else {
    bf16_t* O = (bf16_t*)Op;
#pragma unroll
    for (int g = 0; g < 4; ++g)
#pragma unroll
      for (int e = 0; e < 4; ++e) { bf16_t* orow = O + (size_t)(qrow0 + 8 * g + 4 * hi + e) * PITCH + r32;
#pragma unroll
        for (int c = 0; c < NC; ++c) orow[32 * c] = (bf16_t)(cvtpk(o[c][4 * g + e], 0.f) & 0xffffu); }
  }
  __syncthreads();
}
#undef ATT_MFMA
#undef ATT_DMA
#undef ATT_PV
}
#define GAS __attribute__((address_space(1)))
#define LAS __attribute__((address_space(3)))
typedef unsigned short bf16;
typedef unsigned v4u __attribute__((ext_vector_type(4)));
typedef float f32x4 __attribute__((ext_vector_type(4)));
typedef short bf16x8 __attribute__((ext_vector_type(8)));
typedef GAS unsigned gu32;
typedef GAS unsigned long long gu64;
#define RLX_AGENT __ATOMIC_RELAXED, __HIP_MEMORY_SCOPE_AGENT
#define LDS_WAIT() asm volatile("s_waitcnt lgkmcnt(0)" ::: "memory")
#define VM_WAIT() asm volatile("s_waitcnt vmcnt(0)" ::: "memory")
__device__ __forceinline__ unsigned long long rt() { return __builtin_amdgcn_s_memrealtime(); }
__device__ __forceinline__ unsigned f2bf(float f) { unsigned u = __builtin_bit_cast(unsigned, f); return (u + 0x7fffu + ((u >> 16) & 1u)) >> 16; }
__device__ __forceinline__ unsigned pk2(float lo, float hi) { return f2bf(lo) | (f2bf(hi) << 16); }

#define XB_TMO      128
#define XB_XCNT(j)  (256  + 64 * (j))
#define XB_XSUB(j)  (1280 + 64 * (j))
#define XB_XGEN(j)  (2304 + 64 * (j))
#define XB_TOP      3328
#define XB_TOPGEN   3392
#define XCD_BAR_WORDS 3456
#define XB_SPIN_CAP (1u << 18)

__device__ __forceinline__ unsigned xb_ld(unsigned* p)              { return __hip_atomic_load(p, __ATOMIC_RELAXED, __HIP_MEMORY_SCOPE_AGENT); }
__device__ __forceinline__ unsigned xb_add(unsigned* p, unsigned v) { return __hip_atomic_fetch_add(p, v, __ATOMIC_RELAXED, __HIP_MEMORY_SCOPE_AGENT); }
__device__ __forceinline__ unsigned xb_xcc_id() { return (unsigned)__builtin_amdgcn_s_getreg((3 << 11) | 20) & 0xFu; }
#define XB_SPIN(cond, bar) do { unsigned _sp = 0; while (cond) { __builtin_amdgcn_s_sleep(1); \
    if ((++_sp & 255u) == 0u) { if (xb_ld(&(bar)[XB_TMO])) break; if (_sp > XB_SPIN_CAP) { atomicAdd(&(bar)[XB_TMO], 1u); break; } } } } while (0)

struct XcdBarrier {
    unsigned* bar; unsigned x;
    volatile LAS unsigned* st;
};

__device__ __forceinline__ XcdBarrier xcd_barrier_post(unsigned* bar, volatile LAS unsigned* st) {
    XcdBarrier b; b.bar = bar; b.x = xb_xcc_id(); b.st = st;
    if (threadIdx.x == 0) (void)xb_add(&bar[XB_XCNT(b.x)], 1u);
    return b;
}
__device__ __forceinline__ void xcd_barrier_complete(unsigned* bar, unsigned x, unsigned& nloc, unsigned& nx) {
    const unsigned G = gridDim.x * gridDim.y * gridDim.z;
    unsigned sum, cnt, mine, sp = 0u;
    for (;;) {
        sum = 0u; cnt = 0u; mine = 0u;
#pragma unroll
        for (unsigned j = 0; j < 16; ++j) { const unsigned c = xb_ld(&bar[XB_XCNT(j)]); sum += c; cnt += (c > 0u) ? 1u : 0u; mine = (j == x) ? c : mine; }
        if (sum == G) break;
        __builtin_amdgcn_s_sleep(1);
        if ((++sp & 255u) == 0u) { if (xb_ld(&bar[XB_TMO])) break; if (sp > XB_SPIN_CAP) { atomicAdd(&bar[XB_TMO], 1u); break; } }
    }
    nloc = mine > 0u ? mine : 1u; nx = cnt > 0u ? cnt : 1u;
}

__device__ __forceinline__ void xcd_barrier(const XcdBarrier& b) {
    asm volatile("s_waitcnt vmcnt(0)" ::: "memory");
    __syncthreads();
    if (threadIdx.x == 0) {
        unsigned* bar = b.bar;
        __builtin_amdgcn_s_waitcnt(0);
        unsigned nloc = b.st[0], nx = b.st[1];
        if (nloc == 0u) { xcd_barrier_complete(bar, b.x, nloc, nx); b.st[0] = nloc; b.st[1] = nx; }
        const unsigned old = xb_add(&bar[XB_XSUB(b.x)], 1u);
        const unsigned gen = old / nloc;
        if (old + 1u == (gen + 1u) * nloc) {
            __builtin_amdgcn_fence(__ATOMIC_RELEASE, "agent");
            asm volatile("s_waitcnt vmcnt(0)" ::: "memory");
            const unsigned og = xb_add(&bar[XB_TOP], 1u);
            const unsigned tg = og / nx;
            if (og + 1u == (tg + 1u) * nx) xb_add(&bar[XB_TOPGEN], 1u);
            else XB_SPIN(xb_ld(&bar[XB_TOPGEN]) == tg, bar);
            __builtin_amdgcn_fence(__ATOMIC_ACQUIRE, "agent");
            xb_add(&bar[XB_XGEN(b.x)], 1u);
            asm volatile("s_waitcnt vmcnt(0)" ::: "memory");
        } else {
            XB_SPIN(xb_ld(&bar[XB_XGEN(b.x)]) == gen, bar);
            __builtin_amdgcn_fence(__ATOMIC_ACQUIRE, "agent");
            asm volatile("s_waitcnt vmcnt(0)" ::: "memory");
        }
    }
    __syncthreads();
}
constexpr int NWAVES = 8;
constexpr int BATCH = 2, SEQ = 4096, D = 2048, M = BATCH * SEQ, FF = 5632, NPROJ = 6144;
constexpr float EPS = 1e-6f;
constexpr float C2 = 0.08838834764831845f * 1.4426950408889634f;
constexpr float LAMBDA_INIT = 0.35550906759f;
constexpr size_t MiB = 1u << 20;
constexpr size_t WS_CTL = 0, CTL_ZERO_BYTES = 65536 + 3 * 65536;
constexpr size_t WS_SS = 65536;
constexpr size_t WS_ROPE = 1 * MiB;
constexpr size_t WS_WKVQ = 4 * MiB, WS_WO_B = 28 * MiB, WS_WGU_B = 36 * MiB, WS_WD_B = 80 * MiB;
constexpr size_t WS_AB = 102 * MiB;
constexpr size_t WS_P0 = 134 * MiB, WS_P1 = 166 * MiB, WS_P2 = 198 * MiB;
constexpr size_t WS_ACT = 230 * MiB;
constexpr size_t WS_WQKV_A = 318 * MiB, WS_WO_A = 342 * MiB, WS_WGU_A = 350 * MiB, WS_WD_A = 394 * MiB;
constexpr size_t WS_OB = 318 * MiB;
constexpr size_t WS_XB = 416 * MiB;
constexpr size_t WS_END = 448 * MiB;
constexpr int CW_BAR = 1024;
constexpr int RING_BYTES = 131072, LDSCTL_OFF = RING_BYTES, MISC_OFF = LDSCTL_OFF + 320, LDS_BYTES = 147456;
static_assert(att::LDS_BYTES <= LDS_BYTES && att::LDS_WS >= MISC_OFF + 128 && (2 + 3 * 2) * att::TILE_BYTES <= RING_BYTES && (3 + 4) * att::TILE_BYTES <= RING_BYTES, "attention LDS");

__device__ __forceinline__ float wave_sum(float v) {
#pragma unroll
    for (int o = 1; o < 64; o <<= 1) v += __shfl_xor(v, o);
    return v;
}
__device__ __forceinline__ void transpose_item(const float* __restrict__ W, int K, int N, bf16* WT, int row_off, int gu_map, const float* __restrict__ gain, LAS float* scr, int item, int lane) {
    const int nblk = N / 32, kb = item / nblk, nb = item - kb * nblk, k0 = 64 * kb, n0 = 32 * nb;
    float wv[32];
#pragma unroll
    for (int i = 0; i < 32; ++i) { const int kk = 2 * i + (lane >> 5); wv[i] = __builtin_nontemporal_load(W + (size_t)(k0 + kk) * N + n0 + (lane & 31)); }
    if (gain) {
#pragma unroll
        for (int i = 0; i < 32; ++i) wv[i] *= gain[k0 + 2 * i + (lane >> 5)];
    }
#pragma unroll
    for (int i = 0; i < 32; ++i) scr[(2 * i + (lane >> 5)) * 33 + (lane & 31)] = wv[i];
    LDS_WAIT(); asm volatile("" ::: "memory");
    int drow0 = row_off + n0;
    if (gu_map) { const int half = N / 2, isup = n0 >= half ? 1 : 0, j = n0 - isup * half; drow0 = 256 * (j >> 7) + 128 * isup + (j & 127); }
    const int c = lane & 7;
#pragma unroll
    for (int j = 0; j < 4; ++j) { const int n = (lane >> 3) + 8 * j; const LAS float* s = scr + (8 * c) * 33 + n;
        v4u o; o.x = pk2(s[0 * 33], s[1 * 33]); o.y = pk2(s[2 * 33], s[3 * 33]); o.z = pk2(s[4 * 33], s[5 * 33]); o.w = pk2(s[6 * 33], s[7 * 33]);
        *(GAS v4u*)(WT + (size_t)(drow0 + n) * K + k0 + 8 * c) = o; }
    LDS_WAIT(); asm volatile("" ::: "memory");
}
__device__ __forceinline__ void xb_rows(const float* X, bf16* out, unsigned long long* ss, int gw, int NGW, int lane) {
    for (int m = gw; m < M; m += NGW) {
        const GAS f32x4* xr = (const GAS f32x4*)(X + (size_t)m * D) + lane;
        f32x4 v[8]; float s = 0.f;
#pragma unroll
        for (int j = 0; j < 8; ++j) { v[j] = xr[64 * j]; s += (v[j].x * v[j].x + v[j].y * v[j].y) + (v[j].z * v[j].z + v[j].w * v[j].w); }
        s = wave_sum(s);
        if (lane == 0) ss[m] = (unsigned long long)(s * 16777216.0f);
        GAS unsigned long long* o8 = (GAS unsigned long long*)(out + (size_t)m * D) + lane;
#pragma unroll
        for (int j = 0; j < 8; ++j) o8[64 * j] = (unsigned long long)pk2(v[j].x, v[j].y) | ((unsigned long long)pk2(v[j].z, v[j].w) << 32);
    }
}
__device__ __forceinline__ void rms_rows(const float* X, bf16* out, int gw, int NGW, int lane) {
    for (int m = gw; m < M; m += NGW) {
        const GAS f32x4* xr = (const GAS f32x4*)(X + (size_t)m * D) + lane;
        f32x4 v[8]; float s = 0.f;
#pragma unroll
        for (int j = 0; j < 8; ++j) { v[j] = xr[64 * j]; s += (v[j].x * v[j].x + v[j].y * v[j].y) + (v[j].z * v[j].z + v[j].w * v[j].w); }
        const float r = 1.0f / sqrtf(wave_sum(s) * (1.0f / D) + EPS);
        GAS unsigned long long* o8 = (GAS unsigned long long*)(out + (size_t)m * D) + lane;
#pragma unroll
        for (int j = 0; j < 8; ++j) o8[64 * j] = (unsigned long long)pk2(v[j].x * r, v[j].y * r) | ((unsigned long long)pk2(v[j].z * r, v[j].w * r) << 32);
    }
}
__device__ __forceinline__ float bf2f(unsigned short h) { return __uint_as_float(((unsigned)h) << 16); }
__device__ __forceinline__ void qknorm_rope_row(bf16* row, const float* __restrict__ gain, float sc, const float* __restrict__ cs  , int lane) {
    const int cc = lane & 7;
    float ga[8], gb[8], co[8], si[8];
#pragma unroll
    for (int e = 0; e < 8; ++e) { ga[e] = gain[8 * cc + e]; gb[e] = gain[64 + 8 * cc + e]; co[e] = cs[2 * (8 * cc + e)]; si[e] = cs[2 * (8 * cc + e) + 1]; }
#pragma unroll
    for (int it = 0; it < 2; ++it) {
        bf16* p = row + 128 * (8 * it + (lane >> 3)) + 8 * cc;
        const v4u a = *(const GAS v4u*)p, b = *(const GAS v4u*)(p + 64);
        float xa[8], xb[8]; float ss = 0.f;
#pragma unroll
        for (int e = 0; e < 4; ++e) { xa[2 * e] = __uint_as_float(a[e] << 16); xa[2 * e + 1] = __uint_as_float(a[e] & 0xffff0000u); xb[2 * e] = __uint_as_float(b[e] << 16); xb[2 * e + 1] = __uint_as_float(b[e] & 0xffff0000u); }
#pragma unroll
        for (int e = 0; e < 8; ++e) ss += xa[e] * xa[e] + xb[e] * xb[e];
        ss += __shfl_xor(ss, 1); ss += __shfl_xor(ss, 2); ss += __shfl_xor(ss, 4);
        const float r = 1.0f / sqrtf(ss * (1.0f / 128.0f) + EPS);
        float oa[8], ob[8];
#pragma unroll
        for (int e = 0; e < 8; ++e) { const float ya = xa[e] * r * ga[e], yb = xb[e] * r * gb[e]; oa[e] = (ya * co[e] - yb * si[e]) * sc; ob[e] = (yb * co[e] + ya * si[e]) * sc; }
        v4u wa, wb;
#pragma unroll
        for (int e = 0; e < 4; ++e) { wa[e] = pk2(oa[2 * e], oa[2 * e + 1]); wb[e] = pk2(ob[2 * e], ob[2 * e + 1]); }
        *(GAS v4u*)p = wa; *(GAS v4u*)(p + 64) = wb;
    }
}

struct Args { const float* in[22]; float* out; unsigned char* ws; };
typedef __attribute__((address_space(4))) const Args* ArgsCP;
__device__ __forceinline__ ArgsCP argp() { ArgsCP p = (ArgsCP)__builtin_amdgcn_kernarg_segment_ptr(); asm volatile("" : "+s"(p)); return p; }


#ifndef MK_CG_ALL
#define MK_CG_ALL 0
#endif
#if MK_CG_ALL
#define GSYNC() cg::this_grid().sync()
#else
#define GSYNC() do { XcdBarrier b_; b_.bar = (unsigned*)((gu32*)(argp()->ws + WS_CTL) + CW_BAR); b_.x = xb_xcc_id(); b_.st = (volatile LAS unsigned*)(lds + MISC_OFF) + 8; xcd_barrier(b_); } while (0)
#endif
__device__ __forceinline__ int opaque_tid() { int t = threadIdx.x; asm volatile("" : "+v"(t)); return t; }
namespace att {
__device__ __forceinline__ const float* att_qgain() { return argp()->in[12]; }
__device__ __forceinline__ const float* att_rope() { return (const float*)(argp()->ws + WS_ROPE); }
}
template <int L>
__device__ __forceinline__ void layer_body(LAS unsigned char* lds, unsigned char* ws, const float* x, float* out,
                                           int G, int bx, int vcu, int gw, int NGW) {
    bf16* AB = (bf16*)(ws + WS_AB); bf16* P0 = (bf16*)(ws + WS_P0); bf16* P1 = (bf16*)(ws + WS_P1); bf16* P2 = (bf16*)(ws + WS_P2);
    bf16* ACT = (bf16*)(ws + WS_ACT); bf16* OB = (bf16*)(ws + WS_OB); float* ROPE = (float*)(ws + WS_ROPE);
        bf16* XB = (bf16*)(ws + WS_XB); unsigned long long* SS = (unsigned long long*)(ws + WS_SS);
        {
            pg8::Gemm g{XB, (const bf16*)(ws + (L == 0 ? WS_WQKV_A : WS_WKVQ)), M, NPROJ, D}; pg8::StaticOrder S; S.init(M, NPROJ, G, bx);
            pg8::EpiProj E{P0, D, D, (size_t)(WS_P1 - WS_P0) / 2, L == 0 ? C2 : 1.0f, L == 0 ? SS + 3 * (size_t)M : SS + M, (1.0f / D) * (1.0f / 16777216.0f), EPS};
            pg8::gemm_phase<pg8::EpiProj, pg8::StaticOrder, true, true>(lds, g, S, E);
        }
        GSYNC();
        if constexpr (L == 0) {
            constexpr int TOTAL = 32 * 16; const int per = (TOTAL + G - 1) / G;
            for (int idx = vcu * per; idx < (vcu + 1) * per && idx < TOTAL; ++idx) {
                const int hp = idx >> 4, k = idx & 15, qb = (k & 1) ? 15 - (k >> 1) : (k >> 1);
                const size_t base = (size_t)(hp >> 4) * SEQ * D + 128 * (hp & 15);
                att::attn_unit<0, 4>(lds, P0 + base, P1 + base, P2 + base, (void*)(AB + base), qb * att::QB);
            }
            GSYNC();
        } else {
            const int lane = opaque_tid() & 63;
            for (int m = gw; m < M; m += NGW) qknorm_rope_row(P0 + (size_t)m * D, argp()->in[9], 1.0f, ROPE + (size_t)(m & (SEQ - 1)) * 128, lane);
            GSYNC();
            constexpr int TOTAL = 32 * 16; const int per = (TOTAL + G - 1) / G;
            for (int idx = vcu * per; idx < (vcu + 1) * per && idx < TOTAL; ++idx) {
                const int hp = idx >> 4, k = idx & 15, qb = (k & 1) ? 15 - (k >> 1) : (k >> 1);
                const int c = hp & 1, h = (hp >> 1) & 7, b = hp >> 4;
                const size_t rb = (size_t)b * SEQ * D;
                att::attn_unit<1, 8, true>(lds, P2 + rb + (2 * h + c) * 128, P0 + rb + (2 * h + c) * 128, P1 + rb + 256 * h, (void*)(OB + (size_t)c * M * D + rb + 256 * h), qb * att::QB);
            }
            GSYNC();
            {
                const int lane = opaque_tid() & 63;
                const float a1 = argp()->in[13][lane] * argp()->in[14][lane] + argp()->in[13][lane + 64] * argp()->in[14][lane + 64];
                const float a2 = argp()->in[15][lane] * argp()->in[16][lane] + argp()->in[15][lane + 64] * argp()->in[16][lane + 64];
                const float lam = expf(wave_sum(a1)) - expf(wave_sum(a2)) + LAMBDA_INIT;
                const f32x4 gs = *(const GAS f32x4*)(argp()->in[17] + 4 * lane);
                for (int m = gw; m < M; m += NGW) {
#pragma unroll
                    for (int h = 0; h < 8; ++h) {
                        const size_t off = (size_t)m * D + 256 * h + 4 * lane;
                        const unsigned long long w0 = *(const GAS unsigned long long*)(OB + off), w1 = *(const GAS unsigned long long*)(OB + (size_t)M * D + off);
                        const f32x4 o0 = {__uint_as_float((unsigned)w0 << 16), __uint_as_float((unsigned)w0 & 0xffff0000u), __uint_as_float((unsigned)(w0 >> 32) << 16), __uint_as_float((unsigned)(w0 >> 32) & 0xffff0000u)};
                        const f32x4 o1 = {__uint_as_float((unsigned)w1 << 16), __uint_as_float((unsigned)w1 & 0xffff0000u), __uint_as_float((unsigned)(w1 >> 32) << 16), __uint_as_float((unsigned)(w1 >> 32) & 0xffff0000u)};
                        const f32x4 o = o0 - lam * o1;
                        const float ss = wave_sum((o.x * o.x + o.y * o.y) + (o.z * o.z + o.w * o.w));
                        const float r = (1.0f - LAMBDA_INIT) / sqrtf(ss * (1.0f / 256.0f) + EPS);
                        *(GAS unsigned long long*)(AB + off) = (unsigned long long)pk2(o.x * r * gs.x, o.y * r * gs.y) | ((unsigned long long)pk2(o.z * r * gs.z, o.w * r * gs.w) << 32);
                    }
                }
            }
            GSYNC();
        }
        {
            pg8::Gemm g{AB, (const bf16*)(ws + (L == 0 ? WS_WO_A : WS_WO_B)), M, D, D}; pg8::StaticOrder S; S.init(M, D, G, bx);
            { pg8::EpiRes2<true, false, true> E{(const void*)XB, nullptr, XB, SS + (L == 0 ? 0 : 2 * M), D}; pg8::gemm_phase<pg8::EpiRes2<true, false, true>, pg8::StaticOrder, true, true>(lds, g, S, E); }
        }
        GSYNC();
        {
            pg8::Gemm g{XB, (const bf16*)(ws + (L == 0 ? WS_WGU_A : WS_WGU_B)), M, 2 * FF, D}; pg8::StaticOrder S; S.init(M, 2 * FF, G, bx);
            pg8::EpiSwiglu E{ACT, FF, SS + (L == 0 ? 0 : 2 * M), (1.0f / D) * (1.0f / 16777216.0f), EPS};
            pg8::gemm_phase<pg8::EpiSwiglu, pg8::StaticOrder, true, true>(lds, g, S, E);
            if constexpr (L == 0) {
                if (G == 256 && bx >= 128) {
                    const int t_ = opaque_tid(), lane = t_ & 63, wave = __builtin_amdgcn_readfirstlane(t_ >> 6);
                    LAS float* scr = (LAS float*)(lds + wave * 16384);
                    for (int it = (bx - 128) * NWAVES + wave; it < 32 * 352; it += 128 * NWAVES) transpose_item(argp()->in[20], D, 2 * FF, (bf16*)(ws + WS_WGU_B), 0, 1, argp()->in[19], scr, it, lane);
                }
            } else {
                if (G == 256 && bx >= 128) {
                    const int t_ = opaque_tid(), lane = t_ & 63, wave = __builtin_amdgcn_readfirstlane(t_ >> 6);
                    LAS float* scr = (LAS float*)(lds + wave * 16384);
                    for (int it = (bx - 128) * NWAVES + wave; it < 88 * 64; it += 128 * NWAVES) transpose_item(argp()->in[21], FF, D, (bf16*)(ws + WS_WD_B), 0, 0, nullptr, scr, it, lane);
                }
            }
        }
        GSYNC();
        {
            pg8::Gemm g{ACT, (const bf16*)(ws + (L == 0 ? WS_WD_A : WS_WD_B)), M, D, FF}; pg8::StaticOrder S; S.init(M, D, G, bx);
            if constexpr (L == 0) { pg8::EpiRes2<true, false, true> E{(const void*)XB, nullptr, XB, SS + M, D}; pg8::gemm_phase<pg8::EpiRes2<true, false, true>, pg8::StaticOrder, true, true>(lds, g, S, E); }
            else { pg8::EpiRes2<true, true, false> E{(const void*)XB, out, nullptr, nullptr, D}; pg8::gemm_phase<pg8::EpiRes2<true, true, false>, pg8::StaticOrder, true, true>(lds, g, S, E); }
        }
        if (L == 0) GSYNC();
}

__global__ void __launch_bounds__(NWAVES * 64, 2) fwd_megakernel(Args args) {
    extern __shared__ __attribute__((aligned(16))) unsigned char lds_raw[];
    LAS unsigned char* lds = (LAS unsigned char*)lds_raw;
    volatile LAS unsigned* MISC = (volatile LAS unsigned*)(lds + MISC_OFF);
    const int tid = threadIdx.x, lane = tid & 63, wave = __builtin_amdgcn_readfirstlane(tid >> 6);
    const int G = gridDim.x; const int bx = blockIdx.x;
    const int vcu = (G % 8 == 0) ? (bx % 8) * (G / 8) + bx / 8 : bx;
    const int gw = vcu * NWAVES + wave, NGW = G * NWAVES;
    unsigned char* ws = argp()->ws;
    gu32* ctl = (gu32*)(ws + WS_CTL);
    const float* x = argp()->in[0]; float* out = argp()->out;
    bf16* AB = (bf16*)(ws + WS_AB); bf16* P0 = (bf16*)(ws + WS_P0); bf16* P1 = (bf16*)(ws + WS_P1); bf16* P2 = (bf16*)(ws + WS_P2);
    bf16* ACT = (bf16*)(ws + WS_ACT); bf16* OB = (bf16*)(ws + WS_OB); float* ROPE = (float*)(ws + WS_ROPE);
    for (int u = tid; u < (LDS_BYTES - LDSCTL_OFF) / 4; u += NWAVES * 64) ((LAS unsigned*)(lds + LDSCTL_OFF))[u] = 0u;
    __syncthreads();
    for (unsigned u = (unsigned)(bx * NWAVES * 64 + tid); u < CTL_ZERO_BYTES / 4; u += (unsigned)(G * NWAVES * 64)) ctl[u] = 0u;


    {
        LAS float* scr = (LAS float*)(lds + wave * 16384);
        constexpr int I_QKV = 32 * 192, I_O = 32 * 64, I_GU = 32 * 352, I_D = 88 * 64, I_KV = 32 * 128;
        constexpr int NITEMS = I_QKV + 3 * I_O + 2 * I_GU + 2 * I_D + I_KV;
        for (int it = gw; it < NITEMS; it += NGW) {
            int r = it;
            if (r < I_QKV) { transpose_item(argp()->in[2], D, NPROJ, (bf16*)(ws + WS_WQKV_A), 0, 0, argp()->in[1], scr, r, lane); continue; } r -= I_QKV;
            if (r < I_O)   { transpose_item(argp()->in[3], D, D, (bf16*)(ws + WS_WO_A), 0, 0, nullptr, scr, r, lane); continue; } r -= I_O;
            if (r < I_GU)  { transpose_item(argp()->in[5], D, 2 * FF, (bf16*)(ws + WS_WGU_A), 0, 1, argp()->in[4], scr, r, lane); continue; } r -= I_GU;
            if (r < I_D)   { transpose_item(argp()->in[6], FF, D, (bf16*)(ws + WS_WD_A), 0, 0, nullptr, scr, r, lane); continue; } r -= I_D;
            if (r < I_KV)  { transpose_item(argp()->in[8], D, 2 * D, (bf16*)(ws + WS_WKVQ), 0, 0, argp()->in[7], scr, r, lane); continue; } r -= I_KV;
            if (r < I_O)   { transpose_item(argp()->in[11], D, D, (bf16*)(ws + WS_WKVQ), 2 * D, 0, argp()->in[10], scr, r, lane); continue; } r -= I_O;
            if (r < I_O)   { transpose_item(argp()->in[18], D, D, (bf16*)(ws + WS_WO_B), 0, 0, nullptr, scr, r, lane); continue; } r -= I_O;
            if (r < I_GU)  { if (G != 256) transpose_item(argp()->in[20], D, 2 * FF, (bf16*)(ws + WS_WGU_B), 0, 1, argp()->in[19], scr, r, lane); continue; } r -= I_GU;
            if (G != 256) transpose_item(argp()->in[21], FF, D, (bf16*)(ws + WS_WD_B), 0, 0, nullptr, scr, r, lane);
        }
        xb_rows(x, (bf16*)(ws + WS_XB), (unsigned long long*)(ws + WS_SS) + 3 * (size_t)M, gw, NGW, lane);
        for (int e = (vcu * NWAVES * 64 + tid); e < SEQ * 64; e += G * NWAVES * 64) {
            const int pos = e >> 6, i = e & 63;
            const float inv_freq = powf(10000.0f, -(float)i * (1.0f / 64.0f));
            const float ang = (float)pos * inv_freq;
            const double rev = (double)ang * 0.15915494309189535;
            const float fr = (float)(rev - __builtin_rint(rev));
            ROPE[2 * e] = __builtin_amdgcn_cosf(fr); ROPE[2 * e + 1] = __builtin_amdgcn_sinf(fr);
        }
    }
    cg::this_grid().sync();
    (void)xcd_barrier_post((unsigned*)(ctl + CW_BAR), MISC + 8);

    layer_body<0>(lds, ws, x, out, G, bx, vcu, gw, NGW);
    layer_body<1>(lds, ws, x, out, G, bx, vcu, gw, NGW);
}

extern "C" void kernel_launch(void* const* d_in, const int* in_sizes, int n_in, void* d_out, int out_size, void* d_ws, size_t ws_size, hipStream_t stream) {
    static int grid = 0;
    if (grid == 0) {
        if (n_in != 22 || in_sizes[0] != M * D || out_size != M * D || ws_size < WS_END) { fprintf(stderr, "kernel_launch: unexpected problem shape / workspace (n_in %d, in0 %d, out %d, ws %zu)\n", n_in, n_in > 0 ? in_sizes[0] : -1, out_size, ws_size); grid = -1; return; }
        int dev = 0, cus = 0, per_cu = 0;
        if (hipGetDevice(&dev) != hipSuccess || hipDeviceGetAttribute(&cus, hipDeviceAttributeMultiprocessorCount, dev) != hipSuccess) { grid = -1; return; }
        if (hipFuncSetAttribute((const void*)fwd_megakernel, hipFuncAttributeMaxDynamicSharedMemorySize, LDS_BYTES) != hipSuccess) { fprintf(stderr, "kernel_launch: hipFuncSetAttribute failed\n"); grid = -1; return; }
        if (hipOccupancyMaxActiveBlocksPerMultiprocessor(&per_cu, (const void*)fwd_megakernel, NWAVES * 64, LDS_BYTES) != hipSuccess || per_cu < 1) { fprintf(stderr, "kernel_launch: occupancy query says %d blocks per CU\n", per_cu); (void)hipGetLastError(); per_cu = 1; }
        grid = cus;
    }
    if (grid < 0) return;
    Args a{};
    for (int i = 0; i < 22; ++i) a.in[i] = (const float*)d_in[i];
    a.out = (float*)d_out; a.ws = (unsigned char*)d_ws;
    void* kargs[] = {&a};
    const hipError_t e = hipLaunchCooperativeKernel((const void*)fwd_megakernel, dim3(grid), dim3(NWAVES * 64), kargs, LDS_BYTES, stream);
    if (e != hipSuccess) fprintf(stderr, "kernel_launch: cooperative launch failed: %s (grid %d)\n", hipGetErrorString(e), grid);
}
```

```cpp
#include <hip/hip_runtime.h>
#include <hip/hip_cooperative_groups.h>
#include <cstdio>
#include <cstdint>
#include <cmath>
namespace cg = cooperative_groups;
namespace pg8 {
#define PG8_LAS __attribute__((address_space(3)))
typedef unsigned short bf16_t;
typedef short bf16x8 __attribute__((ext_vector_type(8)));
typedef float f32x4 __attribute__((ext_vector_type(4)));
typedef unsigned u32x4 __attribute__((ext_vector_type(4)));
constexpr int BM = 256, BK = 64, HALF = 128, HTB = HALF * BK * 2  , STAGE_BYTES = 8 * HTB, NXCD = 8, WGM = 8;

__host__ __device__ __forceinline__ int lds_byte(int r, int c) { const int st = (r >> 4) * 2 + (c >> 5), rr = r & 15, cc = c & 31, ob = rr * 64 + cc * 2; return st * 1024 + (ob ^ (((ob >> 9) & 1) << 5)); }
__host__ __device__ __forceinline__ void stage_rc(int b, int& R, int& C) { const int st = b / 1024, sb = b % 1024, swz = sb ^ (((sb >> 9) & 1) << 5); R = (st >> 1) * 16 + swz / 64; C = (st & 1) * 32 + (swz % 64) / 2; }
__host__ __device__ __forceinline__ int perm32(int rho) { const int n = rho >> 4, i = rho & 15; return 8 * (i >> 2) + 4 * n + (i & 3); }

struct Unit { int pm, pn; };
struct Gemm { const bf16_t* A; const bf16_t* Bt; int M, N, K; };

struct StaticOrder {
    int nM, nN, nwg, G, c;
    __host__ __device__ void init(int M, int N, int G_, int c_) { nM = M / BM; nN = N / BM; nwg = nM * nN; G = G_; c = c_; }
    __host__ __device__ bool next(int i, Unit& u) const {
        const long L = (long)i * G + c; if (L >= nwg) return false;
        int wgid = (int)L; { const int q = nwg / NXCD, r = nwg % NXCD, xcd = wgid % NXCD, off = wgid / NXCD; wgid = (xcd < r ? xcd * (q + 1) : r * (q + 1) + (xcd - r) * q) + off; }
        const int nig = WGM * nN, gid = wgid / nig, fm = gid * WGM, gsz = (nM - fm) < WGM ? (nM - fm) : WGM;
        u.pm = fm + ((wgid % nig) % gsz); u.pn = (wgid % nig) / gsz; return true;
    }
    __device__ __forceinline__ void a_ready(const Unit&) const {}
    __device__ __forceinline__ void done(const Unit&) const {}
};

__device__ __forceinline__ unsigned cvt_pk_bf16(float lo, float hi) { unsigned r; asm volatile("v_cvt_pk_bf16_f32 %0, %1, %2" : "=v"(r) : "v"(lo), "v"(hi)); return r; }
typedef float f32x2 __attribute__((ext_vector_type(2)));
__device__ __forceinline__ f32x2 gelu_pk(f32x2 v) {
    const f32x2 av = __builtin_elementwise_abs(v), d = av * 0.2316418882f + 1.0f;
    f32x2 t; t.x = __builtin_amdgcn_rcpf(d.x); t.y = __builtin_amdgcn_rcpf(d.y);
    f32x2 q = t * 0.5307027145f + (-0.7265760135f); q = q * t + 0.7107068705f; q = q * t + (-0.142248368f); q = q * t + 0.127414796f; q = q * t;
    const f32x2 s = (v * v) * (-0.72134752044f);
    f32x2 e; e.x = __builtin_amdgcn_exp2f(s.x); e.y = __builtin_amdgcn_exp2f(s.y);
    const f32x2 m = v * (q * e), r = v - m;
    f32x2 o; o.x = v.x < 0.f ? m.x : r.x; o.y = v.y < 0.f ? m.y : r.y; return o;
}

template <int ACT  > struct EpiBf16 {
    static constexpr bool PERM = true, AFTER_DRAIN = false; static_assert(ACT == 0 || ACT == 1, "EpiBf16: ACT is 0 (none) or 1 (gelu_pk)");
    bf16_t* O; int ldc; const float* bias; int split_cols; size_t split_stride; float scale0;
    __device__ __forceinline__ void operator()(const f32x4 (&acc)[2][2][4][2], const Unit& u, int wr, int wc, int fr, int fq) const {
        const int row0 = u.pm * BM + wr * 64 + fr; int colt = u.pn * BM; bf16_t* base = O;
        float sc = 1.f; if (split_cols) { const int t = colt / split_cols; base += (size_t)t * split_stride; colt -= t * split_cols; if (t == 0) sc = scale0; }
        const int col0 = colt + wc * 32 + 8 * fq, bcol0 = u.pn * BM + wc * 32 + 8 * fq;
        f32x4 bv[2][2];
#pragma unroll
        for (int bj = 0; bj < 2; ++bj)
#pragma unroll
            for (int n = 0; n < 2; ++n) bv[bj][n] = bias ? *(const f32x4*)(bias + bcol0 + bj * HALF + 4 * n) : (f32x4){0.f, 0.f, 0.f, 0.f};
#pragma unroll
        for (int ai = 0; ai < 2; ++ai)
#pragma unroll
            for (int m = 0; m < 4; ++m) { bf16_t* rowp = base + (size_t)(row0 + ai * HALF + m * 16) * ldc + col0;
#pragma unroll
                for (int bj = 0; bj < 2; ++bj) { f32x4 v0 = acc[ai][bj][m][0] + bv[bj][0], v1 = acc[ai][bj][m][1] + bv[bj][1];
                    if (ACT == 1) { f32x2 a = gelu_pk((f32x2){v0[0], v0[1]}), b = gelu_pk((f32x2){v0[2], v0[3]}), c = gelu_pk((f32x2){v1[0], v1[1]}), d = gelu_pk((f32x2){v1[2], v1[3]});
                        v0 = (f32x4){a.x, a.y, b.x, b.y}; v1 = (f32x4){c.x, c.y, d.x, d.y}; }
                    v0 = v0 * sc; v1 = v1 * sc; u32x4 w; w.x = cvt_pk_bf16(v0[0], v0[1]); w.y = cvt_pk_bf16(v0[2], v0[3]); w.z = cvt_pk_bf16(v1[0], v1[1]); w.w = cvt_pk_bf16(v1[2], v1[3]);
                    *(u32x4*)(rowp + bj * HALF) = w; } }
    }
};
struct EpiRes {
    static constexpr bool PERM = false, AFTER_DRAIN = false;
    const float* base; float* out; int ldc;
    __device__ __forceinline__ void operator()(const f32x4 (&acc)[2][2][4][2], const Unit& u, int wr, int wc, int fr, int fq) const {
        const int row0 = u.pm * BM + wr * 64 + fr, col0 = u.pn * BM + wc * 32 + 4 * fq;
#pragma unroll
        for (int ai = 0; ai < 2; ++ai)
#pragma unroll
            for (int m = 0; m < 4; ++m) { const size_t off = (size_t)(row0 + ai * HALF + m * 16) * ldc + col0;
#pragma unroll
                for (int bj = 0; bj < 2; ++bj)
#pragma unroll
                    for (int n = 0; n < 2; ++n) { const f32x4 b = *(const f32x4*)(base + off + bj * HALF + n * 16); *(f32x4*)(out + off + bj * HALF + n * 16) = b + acc[ai][bj][m][n]; }  asm volatile("" ::: "memory"); }
    }
};
__device__ __forceinline__ float u64_to_f32(unsigned long long v) { return __builtin_fmaf((float)(unsigned)(v >> 32), 4294967296.0f, (float)(unsigned)v); }
struct EpiSwiglu {
    static constexpr bool PERM = true, AFTER_DRAIN = false;
    bf16_t* O; int ldo; const unsigned long long* ss; float inv_d, eps;
    static __device__ __forceinline__ float sg(float g, float u) { return g * u * __builtin_amdgcn_rcpf(1.0f + __builtin_amdgcn_exp2f(-1.4426950408889634f * g)); }
    __device__ __forceinline__ void operator()(const f32x4 (&acc)[2][2][4][2], const Unit& u, int wr, int wc, int fr, int fq) const {
        const int row0 = u.pm * BM + wr * 64 + fr, col0 = u.pn * HALF + wc * 32 + 8 * fq;
        unsigned long long sv[2][4];
#pragma unroll
        for (int ai = 0; ai < 2; ++ai)
#pragma unroll
            for (int m = 0; m < 4; ++m) sv[ai][m] = ss[row0 + ai * HALF + m * 16];
#pragma unroll
        for (int ai = 0; ai < 2; ++ai)
#pragma unroll
            for (int m = 0; m < 4; ++m) { const int row = row0 + ai * HALF + m * 16; bf16_t* rowp = O + (size_t)row * ldo + col0;
                const float r = __builtin_amdgcn_rsqf(u64_to_f32(sv[ai][m]) * inv_d + eps);
                const float a = -1.4426950408889634f * r, r2 = r * r;
                f32x4 o4[2];
#pragma unroll
                for (int n = 0; n < 2; ++n) { const f32x4 g = acc[ai][0][m][n], uu = acc[ai][1][m][n]; const f32x4 t = g * a;
                    f32x4 d; d[0] = __builtin_amdgcn_exp2f(t[0]); d[1] = __builtin_amdgcn_exp2f(t[1]); d[2] = __builtin_amdgcn_exp2f(t[2]); d[3] = __builtin_amdgcn_exp2f(t[3]);
                    d = d + 1.0f;
                    f32x4 iv; iv[0] = __builtin_amdgcn_rcpf(d[0]); iv[1] = __builtin_amdgcn_rcpf(d[1]); iv[2] = __builtin_amdgcn_rcpf(d[2]); iv[3] = __builtin_amdgcn_rcpf(d[3]);
                    o4[n] = (g * uu) * (iv * r2); }
                u32x4 w; w.x = cvt_pk_bf16(o4[0][0], o4[0][1]); w.y = cvt_pk_bf16(o4[0][2], o4[0][3]); w.z = cvt_pk_bf16(o4[1][0], o4[1][1]); w.w = cvt_pk_bf16(o4[1][2], o4[1][3]);
                *(u32x4*)rowp = w; }
    }
};


struct EpiResNorm {
    static constexpr bool PERM = false, AFTER_DRAIN = false;
    const float* base; float* out; bf16_t* xb; float* ss; int ldc;
    __device__ __forceinline__ void operator()(const f32x4 (&acc)[2][2][4][2], const Unit& u, int wr, int wc, int fr, int fq) const {
        const int row0 = u.pm * BM + wr * 64 + fr, col0 = u.pn * BM + wc * 32 + 4 * fq;
#pragma unroll
        for (int ai = 0; ai < 2; ++ai)
#pragma unroll
            for (int m = 0; m < 4; ++m) { const int row = row0 + ai * HALF + m * 16; const size_t off = (size_t)row * ldc + col0; float s = 0.f;
#pragma unroll
                for (int bj = 0; bj < 2; ++bj)
#pragma unroll
                    for (int n = 0; n < 2; ++n) { const f32x4 b = *(const f32x4*)(base + off + bj * HALF + n * 16); const f32x4 v = b + acc[ai][bj][m][n]; *(f32x4*)(out + off + bj * HALF + n * 16) = v;
                        s += (v[0] * v[0] + v[1] * v[1]) + (v[2] * v[2] + v[3] * v[3]);
                        unsigned long long w = (unsigned long long)cvt_pk_bf16(v[0], v[1]) | ((unsigned long long)cvt_pk_bf16(v[2], v[3]) << 32);
                        *(unsigned long long*)(xb + off + bj * HALF + n * 16) = w; }
                s += __shfl_xor(s, 16); s += __shfl_xor(s, 32);
                if (fq == 0) atomicAdd(ss + row, s);
                asm volatile("" ::: "memory"); }
    }
};
struct EpiProj {
    static constexpr bool PERM = true, AFTER_DRAIN = false;
    bf16_t* O; int ldc; int split_cols; size_t split_stride; float scale0; const unsigned long long* ss; float inv_d, eps;
    __device__ __forceinline__ void operator()(const f32x4 (&acc)[2][2][4][2], const Unit& u, int wr, int wc, int fr, int fq) const {
        const int row0 = u.pm * BM + wr * 64 + fr; int colt = u.pn * BM; bf16_t* base = O;
        float sc = 1.f; { const int t = colt / split_cols; base += (size_t)t * split_stride; colt -= t * split_cols; if (t == 0) sc = scale0; }
        const int col0 = colt + wc * 32 + 8 * fq;
        unsigned long long sv[2][4];
#pragma unroll
        for (int ai = 0; ai < 2; ++ai)
#pragma unroll
            for (int m = 0; m < 4; ++m) sv[ai][m] = ss ? ss[row0 + ai * HALF + m * 16] : 0ull;
#pragma unroll
        for (int ai = 0; ai < 2; ++ai)
#pragma unroll
            for (int m = 0; m < 4; ++m) { const int row = row0 + ai * HALF + m * 16; bf16_t* rowp = base + (size_t)row * ldc + col0;
                const float r = ss ? sc * __builtin_amdgcn_rsqf(u64_to_f32(sv[ai][m]) * inv_d + eps) : sc;
#pragma unroll
                for (int bj = 0; bj < 2; ++bj) { const f32x4 v0 = acc[ai][bj][m][0] * r, v1 = acc[ai][bj][m][1] * r;
                    u32x4 w; w.x = cvt_pk_bf16(v0[0], v0[1]); w.y = cvt_pk_bf16(v0[2], v0[3]); w.z = cvt_pk_bf16(v1[0], v1[1]); w.w = cvt_pk_bf16(v1[2], v1[3]);
                    *(u32x4*)(rowp + bj * HALF) = w; } }
    }
};

template <bool BASE_BF16, bool OUT_F32, bool WRITE_XB> struct EpiRes2 {
    static constexpr bool PERM = false, AFTER_DRAIN = false;
    const void* base; float* out; bf16_t* xb; unsigned long long* ss; int ldc;
    __device__ __forceinline__ void operator()(const f32x4 (&acc)[2][2][4][2], const Unit& u, int wr, int wc, int fr, int fq) const {
        const int row0 = u.pm * BM + wr * 64 + fr, col0 = u.pn * BM + wc * 32 + 4 * fq;
#pragma unroll
        for (int ai = 0; ai < 2; ++ai)
#pragma unroll
            for (int m = 0; m < 4; ++m) { const int row = row0 + ai * HALF + m * 16; const size_t off = (size_t)row * ldc + col0; float s = 0.f;
#pragma unroll
                for (int bj = 0; bj < 2; ++bj)
#pragma unroll
                    for (int n = 0; n < 2; ++n) { const size_t o2 = off + bj * HALF + n * 16; f32x4 b;
                        if (BASE_BF16) { const unsigned long long w = *(const unsigned long long*)((const bf16_t*)base + o2);
                            b = (f32x4){__uint_as_float((unsigned)w << 16), __uint_as_float((unsigned)w & 0xffff0000u), __uint_as_float((unsigned)(w >> 32) << 16), __uint_as_float((unsigned)(w >> 32) & 0xffff0000u)}; }
                        else b = *(const f32x4*)((const float*)base + o2);
                        const f32x4 v = b + acc[ai][bj][m][n];
                        if (OUT_F32) *(f32x4*)(out + o2) = v;
                        s += (v[0] * v[0] + v[1] * v[1]) + (v[2] * v[2] + v[3] * v[3]);
                        if (WRITE_XB) *(unsigned long long*)(xb + o2) = (unsigned long long)cvt_pk_bf16(v[0], v[1]) | ((unsigned long long)cvt_pk_bf16(v[2], v[3]) << 32); }
                if (ss) { s += __shfl_xor(s, 16); s += __shfl_xor(s, 32); if (fq == 0) atomicAdd(ss + row, (unsigned long long)(s * 16777216.0f)); }
                asm volatile("" ::: "memory"); }
    }
};
template <class Epi, class Sched, bool ALIGN_EPI = false, bool SP2 = false>
__device__ __forceinline__ void gemm_phase(PG8_LAS unsigned char* lds, const Gemm g, const Sched& S, const Epi& E) {
    int tid_ = threadIdx.x; asm volatile("" : "+v"(tid_));
    const int tid = tid_, wid = __builtin_amdgcn_readfirstlane(tid >> 6), lane = tid & 63, wr = wid >> 2, wc = wid & 3, fr = lane & 15, fq = lane >> 4;
    const int K = g.K, nt = K / BK;
    unsigned voffA[2], voffB[2];
#pragma unroll
    for (int i = 0; i < 2; ++i) { int R, C; stage_rc(tid * 16 + i * 8192, R, C); const int Rb = Epi::PERM ? ((R & ~31) + perm32(R & 31)) : R;
        voffA[i] = (unsigned)(R * K + C) * 2u; voffB[i] = (unsigned)(Rb * K + C) * 2u; }
    const size_t kstep = (size_t)(BK * 2);
    const size_t hstep = (size_t)HALF * K * 2;
    const size_t tstep = 2 * hstep;
    const unsigned ldsw = (unsigned)wid * 1024u;
    const int aoff = lds_byte(wr * 64 + fr, fq * 8), boff = lds_byte(wc * 32 + fr, fq * 8);
#define PG8_SA(b, h) (((b) * 2 + (h)) * HTB)
#define PG8_SB(b, h) ((4 + (b) * 2 + (h)) * HTB)
#define PG8_STAGE(bufoff, gbase, voff) do { _Pragma("unroll") for (int _i = 0; _i < 2; ++_i) \
        __builtin_amdgcn_global_load_lds((const unsigned*)((const char*)(gbase) + (voff)[_i]), (PG8_LAS unsigned*)(lds + (bufoff) + ldsw + _i * 8192), 16, 0, 0); } while (0)
#define PG8_LDA(dst, b, h) do { _Pragma("unroll") for (int m = 0; m < 4; ++m) _Pragma("unroll") for (int k = 0; k < 2; ++k) dst[m][k] = *(const PG8_LAS bf16x8*)(lds + PG8_SA(b, h) + aoff + m * 2048 + k * 1024); } while (0)
#define PG8_LDB(dst, b, h) do { _Pragma("unroll") for (int n = 0; n < 2; ++n) _Pragma("unroll") for (int k = 0; k < 2; ++k) dst[n][k] = *(const PG8_LAS bf16x8*)(lds + PG8_SB(b, h) + boff + n * 2048 + k * 1024); } while (0)
#define PG8_MMA(ai, bj, At, Bt) do { __builtin_amdgcn_s_setprio(1); _Pragma("unroll") for (int m = 0; m < 4; ++m) _Pragma("unroll") for (int n = 0; n < 2; ++n) _Pragma("unroll") for (int k = 0; k < 2; ++k) \
        acc[ai][bj][m][n] = __builtin_amdgcn_mfma_f32_16x16x32_bf16(Bt[n][k], At[m][k], acc[ai][bj][m][n], 0, 0, 0); __builtin_amdgcn_s_setprio(0); } while (0)
#define PG8_WAIT_V(n) asm volatile("s_waitcnt vmcnt(" #n ")" ::: "memory")
#define PG8_WAIT_L(n) asm volatile("s_waitcnt lgkmcnt(" #n ")" ::: "memory")
#define PG8_BAR __builtin_amdgcn_s_barrier()
#define PG8_SCHED __builtin_amdgcn_sched_barrier(0)
    Unit cur, nxt; int ui = 0;
    if (!S.next(0, cur)) return;
    f32x4 acc[2][2][4][2];
#pragma unroll
    for (int a = 0; a < 2; ++a)
#pragma unroll
        for (int b = 0; b < 2; ++b)
#pragma unroll
            for (int m = 0; m < 4; ++m)
#pragma unroll
                for (int n = 0; n < 2; ++n) acc[a][b][m][n] = (f32x4){0.f, 0.f, 0.f, 0.f};
    bf16x8 At[4][2], B0[2][2], B1[2][2];
    const char* cA = (const char*)g.A + (size_t)cur.pm * tstep; const char* cB = (const char*)g.Bt + (size_t)cur.pn * tstep;
    S.a_ready(cur);
    if constexpr (SP2) {
        PG8_STAGE(PG8_SB(0, 0), cB, voffB); PG8_STAGE(PG8_SB(0, 1), cB + hstep, voffB); PG8_STAGE(PG8_SA(0, 0), cA, voffA); PG8_STAGE(PG8_SA(0, 1), cA + hstep, voffA);
        if (wr == 1) PG8_BAR;
        PG8_WAIT_V(2); PG8_BAR;
        PG8_STAGE(PG8_SB(1, 0), cB + kstep, voffB); PG8_STAGE(PG8_SA(1, 0), cA + kstep, voffA); PG8_STAGE(PG8_SB(1, 1), cB + hstep + kstep, voffB);
        PG8_WAIT_V(6); PG8_BAR;
    } else {
        PG8_STAGE(PG8_SB(0, 0), cB, voffB); PG8_STAGE(PG8_SA(0, 0), cA, voffA); PG8_STAGE(PG8_SB(0, 1), cB + hstep, voffB); PG8_STAGE(PG8_SA(0, 1), cA + hstep, voffA);
        if (wr == 1) PG8_BAR;
        PG8_WAIT_V(4); PG8_BAR;
        PG8_STAGE(PG8_SB(1, 0), cB + kstep, voffB); PG8_STAGE(PG8_SA(1, 0), cA + kstep, voffA); PG8_STAGE(PG8_SB(1, 1), cB + hstep + kstep, voffB);
        PG8_WAIT_V(6); PG8_BAR;
    }
    for (;;) {
        const bool has_next = S.next(ui + 1, nxt);
        const char* nA = has_next ? (const char*)g.A + (size_t)nxt.pm * tstep : cA; const char* nB = has_next ? (const char*)g.Bt + (size_t)nxt.pn * tstep : cB;
        for (int t = 0; t < nt; t += 2) {
            const bool last = (t == nt - 2);
            const char* a1 = cA + (size_t)(t + 1) * kstep;
            const char* a2 = last ? nA : cA + (size_t)(t + 2) * kstep; const char* b2 = last ? nB : cB + (size_t)(t + 2) * kstep;
            const char* a3 = a2 + kstep; const char* b3 = b2 + kstep;
            if (last && has_next) S.a_ready(nxt);
            if constexpr (SP2) {
            PG8_LDB(B0, 0, 0); PG8_LDB(B1, 0, 1); PG8_SCHED; PG8_LDA(At, 0, 0); PG8_STAGE(PG8_SA(1, 1), a1 + hstep, voffA);
            PG8_WAIT_V(8); PG8_WAIT_L(0); PG8_BAR; PG8_MMA(0, 0, At, B0); PG8_MMA(0, 1, At, B1); PG8_BAR; PG8_SCHED;
            PG8_LDA(At, 0, 1); PG8_STAGE(PG8_SB(0, 0), b2, voffB); PG8_STAGE(PG8_SB(0, 1), b2 + hstep, voffB); PG8_STAGE(PG8_SA(0, 0), a2, voffA);
            PG8_WAIT_V(8); PG8_WAIT_L(0); PG8_BAR; PG8_MMA(1, 0, At, B0); PG8_MMA(1, 1, At, B1); PG8_BAR; PG8_SCHED;
            PG8_LDB(B0, 1, 0); PG8_LDB(B1, 1, 1); PG8_SCHED; PG8_LDA(At, 1, 0); PG8_STAGE(PG8_SA(0, 1), a2 + hstep, voffA);
            PG8_WAIT_V(8); PG8_WAIT_L(0); PG8_BAR; PG8_MMA(0, 0, At, B0); PG8_MMA(0, 1, At, B1); PG8_BAR; PG8_SCHED;
            PG8_LDA(At, 1, 1); PG8_STAGE(PG8_SB(1, 0), b3, voffB); PG8_STAGE(PG8_SB(1, 1), b3 + hstep, voffB); PG8_STAGE(PG8_SA(1, 0), a3, voffA);
            PG8_WAIT_V(8); PG8_WAIT_L(0); PG8_BAR; PG8_MMA(1, 0, At, B0); PG8_MMA(1, 1, At, B1); PG8_BAR; PG8_SCHED;
            } else {
            PG8_LDB(B0, 0, 0); PG8_SCHED; PG8_LDA(At, 0, 0); PG8_STAGE(PG8_SA(1, 1), a1 + hstep, voffA);
            PG8_WAIT_L(8); PG8_BAR; PG8_WAIT_L(0); PG8_MMA(0, 0, At, B0); PG8_BAR; PG8_SCHED;
            PG8_LDB(B1, 0, 1); PG8_STAGE(PG8_SB(0, 0), b2, voffB);
            PG8_BAR; PG8_WAIT_L(0); PG8_MMA(0, 1, At, B1); PG8_BAR;
            PG8_LDA(At, 0, 1); PG8_STAGE(PG8_SA(0, 0), a2, voffA);
            PG8_BAR; PG8_WAIT_L(0); PG8_MMA(1, 0, At, B0); PG8_BAR; PG8_SCHED;
            PG8_STAGE(PG8_SB(0, 1), b2 + hstep, voffB);
            PG8_WAIT_V(6); PG8_BAR; PG8_MMA(1, 1, At, B1); PG8_BAR;
            PG8_LDB(B0, 1, 0); PG8_SCHED; PG8_LDA(At, 1, 0); PG8_STAGE(PG8_SA(0, 1), a2 + hstep, voffA);
            PG8_WAIT_L(8); PG8_BAR; PG8_WAIT_L(0); PG8_MMA(0, 0, At, B0); PG8_BAR; PG8_SCHED;
            PG8_LDB(B1, 1, 1); PG8_STAGE(PG8_SB(1, 0), b3, voffB);
            PG8_BAR; PG8_WAIT_L(0); PG8_MMA(0, 1, At, B1); PG8_BAR;
            PG8_LDA(At, 1, 1); PG8_STAGE(PG8_SA(1, 0), a3, voffA);
            PG8_BAR; PG8_WAIT_L(0); PG8_MMA(1, 0, At, B0); PG8_BAR; PG8_SCHED;
            PG8_STAGE(PG8_SB(1, 1), b3 + hstep, voffB);
            PG8_WAIT_V(6); PG8_BAR; PG8_MMA(1, 1, At, B1); PG8_BAR;
            }
        }
        if constexpr (ALIGN_EPI) { if (wr == 0) PG8_BAR; }
        if constexpr (!Epi::AFTER_DRAIN) { E(acc, cur, wr, wc, fr, fq); S.done(cur); }
        if (!has_next) break;
#pragma unroll
        for (int a = 0; a < 2; ++a)
#pragma unroll
            for (int b = 0; b < 2; ++b)
#pragma unroll
                for (int m = 0; m < 4; ++m)
#pragma unroll
                    for (int n = 0; n < 2; ++n) acc[a][b][m][n] = (f32x4){0.f, 0.f, 0.f, 0.f};
        cur = nxt; cA = nA; cB = nB; ++ui;
        if constexpr (ALIGN_EPI) { if (wr == 1) PG8_BAR; }
    }
    PG8_WAIT_V(0);
    if constexpr (!ALIGN_EPI) { if (wr == 0) PG8_BAR; }
    PG8_BAR;
    if constexpr (Epi::AFTER_DRAIN) { E.fused(acc, cur, wr, wc, fr, fq, lds, wid, lane); S.done(cur); }
#undef PG8_SA
#undef PG8_SB
#undef PG8_STAGE
#undef PG8_LDA
#undef PG8_LDB
#undef PG8_MMA
#undef PG8_WAIT_V
#undef PG8_WAIT_L
#undef PG8_BAR
#undef PG8_SCHED
}
}
namespace att {
#define ATT_LAS __attribute__((address_space(3)))
typedef unsigned short bf16_t;
typedef short bf16x8 __attribute__((ext_vector_type(8)));
typedef short s16x4 __attribute__((ext_vector_type(4)));
typedef short v4i16_t __attribute__((ext_vector_type(4)));
typedef float f32x16 __attribute__((ext_vector_type(16)));
typedef float f32x4 __attribute__((ext_vector_type(4)));
typedef unsigned u32x4 __attribute__((ext_vector_type(4)));
typedef float f32x2_t __attribute__((ext_vector_type(2)));
typedef __bf16 bf16x2_t __attribute__((ext_vector_type(2)));
constexpr int SEQ = 4096, PITCH = 2048, QB = 256, KVB = 64, TILE_BYTES = 16384;
constexpr int LDS_K = 0, LDS_V = 2 * TILE_BYTES, LDS_WS = 131072 + 2048, LDS_FLAG = LDS_WS + 8 * 256, LDS_BYTES = LDS_FLAG + 64;
constexpr float SB_DONE = -160.0f;
__device__ __forceinline__ unsigned off_b(unsigned row, unsigned ch) { return 256u * row + 16u * (ch ^ (((row & 3u) << 2) | ((row >> 2) & 3u))); }
__device__ __forceinline__ unsigned cvtpk(float lo, float hi) { f32x2_t v = {lo, hi}; bf16x2_t b = __builtin_convertvector(v, bf16x2_t); return __builtin_bit_cast(unsigned, b); }
__device__ __forceinline__ s16x4 vtr(const ATT_LAS unsigned char* p) { return __builtin_bit_cast(s16x4, __builtin_amdgcn_ds_read_tr16_b64_v4i16((ATT_LAS v4i16_t*)p)); }
#define ATT_MFMA(a, b, c) __builtin_amdgcn_mfma_f32_32x32x16_bf16((a), (b), (c), 0, 0, 0)

__device__ __forceinline__ const float* att_qgain();
__device__ __forceinline__ const float* att_rope();
template <int MODE, int NC, bool QROPE = false>
__device__ __forceinline__ void attn_unit(ATT_LAS unsigned char* lds, const bf16_t* __restrict__ Qp, const bf16_t* __restrict__ Kp, const bf16_t* __restrict__ Vp, void* Op, int q0) {
  int tid_ = threadIdx.x; asm volatile("" : "+v"(tid_));
  const int tid = tid_, lane = tid & 63, r32 = lane & 31, hi = lane >> 5;
  const int wid = __builtin_amdgcn_readfirstlane(tid >> 6);
  const int qrow0 = q0 + 32 * wid, t = qrow0 + r32;
  const int NT = (q0 + QB) / KVB;
  constexpr int VBUF = (NC / 4) * TILE_BYTES;
#define ATT_DMA(jt_, kbuf_, vbuf_) do { const size_t go_ = (size_t)(KVB * (jt_)) * PITCH; unsigned l_ = (unsigned)lane; asm volatile("" : "+v"(l_)); unsigned kgl[2]; \
    _Pragma("unroll") for (int i2 = 0; i2 < 2; ++i2) { const unsigned pc = 2u * wid + i2, rr = 4u * pc + (l_ >> 4), ch = (l_ & 15u) ^ (((l_ >> 4) & 3u) << 2 | (pc & 3u)); kgl[i2] = rr * PITCH + 8u * ch; } \
    _Pragma("unroll") for (int i2 = 0; i2 < 2; ++i2) { \
      __builtin_amdgcn_global_load_lds((const unsigned*)(Kp + go_ + kgl[i2]), (ATT_LAS unsigned*)(lds + LDS_K + (kbuf_) * TILE_BYTES + wid * 2048 + i2 * 1024), 16, 0, 0); \
      _Pragma("unroll") for (int hf = 0; hf < NC / 4; ++hf) \
        __builtin_amdgcn_global_load_lds((const unsigned*)(Vp + go_ + 128 * hf + kgl[i2]), (ATT_LAS unsigned*)(lds + LDS_V + (vbuf_) * VBUF + hf * TILE_BYTES + wid * 2048 + i2 * 1024), 16, 0, 0); } } while (0)
  ATT_DMA(MODE == 0 ? NT - 1 : 0, 0, 0);
  bf16x8 qf[8];
#pragma unroll
  for (int s = 0; s < 8; ++s) qf[s] = *(const bf16x8*)(Qp + (size_t)t * PITCH + 16 * s + 8 * hi);
  if (QROPE) {
    const float* __restrict__ qgain = att_qgain(); const float* __restrict__ rope = att_rope(); constexpr float qscale = 0.08838834764831845f * 1.4426950408889634f;
    float ss = 0.f;
#pragma unroll
    for (int s = 0; s < 8; ++s)
#pragma unroll
      for (int e = 0; e < 8; ++e) { const float v = __uint_as_float(((unsigned)(unsigned short)qf[s][e]) << 16); ss += v * v; }
    ss += __shfl_xor(ss, 32);
    const float rr = 1.0f / sqrtf(ss * (1.0f / 128.0f) + 1e-6f);
    const float* cs = rope + (size_t)t * 128;
#pragma unroll
    for (int s = 0; s < 4; ++s) {
      u32x4 wa, wb;
#pragma unroll
      for (int e = 0; e < 8; e += 2) {
        float oa[2], ob[2];
#pragma unroll
        for (int h2 = 0; h2 < 2; ++h2) { const int i = 16 * s + 8 * hi + e + h2;
          const float xa = __uint_as_float(((unsigned)(unsigned short)qf[s][e + h2]) << 16), xb = __uint_as_float(((unsigned)(unsigned short)qf[s + 4][e + h2]) << 16);
          const float ya = xa * rr * qgain[i], yb = xb * rr * qgain[64 + i], co = cs[2 * i], si = cs[2 * i + 1];
          oa[h2] = (ya * co - yb * si) * qscale; ob[h2] = (yb * co + ya * si) * qscale; }
        wa[e >> 1] = cvtpk(oa[0], oa[1]); wb[e >> 1] = cvtpk(ob[0], ob[1]);
      }
      qf[s] = __builtin_bit_cast(bf16x8, wa); qf[s + 4] = __builtin_bit_cast(bf16x8, wb);
    }
  }
  const unsigned kbase = 256u * (unsigned)r32, kx = 16u * ((unsigned)hi ^ ((((unsigned)r32 & 3u) << 2) | (((unsigned)r32 >> 2) & 3u)));
  const unsigned vq = ((unsigned)lane & 15u) >> 2;
  unsigned vbase[2];
  { const unsigned p = (unsigned)lane & 3u, blk = ((unsigned)lane >> 4) & 1u, low = 2u * blk + (p >> 1);
#pragma unroll
    for (int jj = 0; jj < 2; ++jj) vbase[jj] = 256u * (8u * jj + 4u * hi + vq) + 16u * (low ^ (2u * jj + hi)) + 8u * (p & 1u); }
  ATT_LAS float* wsf = (ATT_LAS float*)(lds + LDS_WS) + wid * 64;
  ATT_LAS unsigned* flags = (ATT_LAS unsigned*)(lds + LDS_FLAG);
  f32x16 o[NC];
#pragma unroll
  for (int c = 0; c < NC; ++c)
#pragma unroll
    for (int r = 0; r < 16; ++r) o[c][r] = 0.f;
  float m_run = -INFINITY, l_run = 0.f, carry = MODE == 0 ? 1.0f : 0.f;
  bool wdone = false;
  const bool lag = wid >= 4;
  bool pend = false; unsigned pvb = 0u;
  u32x4 pk[4];
#pragma unroll
  for (int s4 = 0; s4 < 4; ++s4) pk[s4] = (u32x4){0u, 0u, 0u, 0u};
#define ATT_PV(VB_) do { const ATT_LAS unsigned char* vb = (VB_); __builtin_amdgcn_s_setprio(1); \
    _Pragma("unroll") for (int s4 = 0; s4 < 4; ++s4) { const bf16x8 pa = __builtin_bit_cast(bf16x8, pk[s4]); \
      _Pragma("unroll") for (int c = 0; c < NC; ++c) { const unsigned vo = 64u * ((unsigned)(c & 3) ^ vq) + (c >> 2) * TILE_BYTES + 4096 * s4; \
        const s16x4 lo = vtr(vb + vbase[0] + vo), hh = vtr(vb + vbase[1] + vo); \
        const bf16x8 vf = __builtin_shufflevector(lo, hh, 0, 1, 2, 3, 4, 5, 6, 7); \
        o[c] = ATT_MFMA(pa, vf, o[c]); } \
      if (NC == 8) __builtin_amdgcn_sched_barrier(0); } \
    __builtin_amdgcn_s_setprio(0); } while (0)
  asm volatile("s_waitcnt vmcnt(0)" ::: "memory");
  __syncthreads();
  int vcur = 0;
  for (int i = 0; i < NT; ++i) {
    const int jt = MODE == 0 ? NT - 1 - i : i; const int buf = i & 1; const int kv0 = KVB * jt;
    const bool more = i + 1 < NT;
    const int vnext = vcur == 2 ? 0 : vcur + 1;
    if (more) ATT_DMA(MODE == 0 ? jt - 1 : jt + 1, buf ^ 1, vnext);
    if (lag && pend) { ATT_PV(lds + LDS_V + pvb); pend = false; }
    const bool active = MODE == 0 ? (kv0 < qrow0 + 31 && !wdone) : (kv0 <= qrow0 + 31);
    f32x16 p0, p1;
    if (active) {
      const ATT_LAS unsigned char* kb = lds + LDS_K + buf * TILE_BYTES;
#pragma unroll
      for (int r = 0; r < 16; ++r) { p0[r] = 0.f; p1[r] = 0.f; }
      __builtin_amdgcn_s_setprio(1);
#pragma unroll
      for (int s = 0; s < 8; ++s) {
        const unsigned ko = kbase + ((32u * s) ^ kx);
        const bf16x8 k0 = *(const ATT_LAS bf16x8*)(kb + ko);
        const bf16x8 k1 = *(const ATT_LAS bf16x8*)(kb + ko + 8192);
        p0 = ATT_MFMA(k0, qf[s], p0); p1 = ATT_MFMA(k1, qf[s], p1);
      }
      __builtin_amdgcn_s_setprio(0);
      if (MODE == 1) {
        const bool full = (kv0 + 63 <= qrow0);
        if (!full) {
#pragma unroll
          for (int r = 0; r < 16; ++r) { const int kv = kv0 + (r & 3) + 8 * (r >> 2) + 4 * hi; if (kv > t) p0[r] = -INFINITY; if (kv + 32 > t) p1[r] = -INFINITY; }
        }
        float mx = __builtin_fmaxf(__builtin_fmaxf(p0[0], p1[0]), __builtin_fmaxf(p0[1], p1[1]));
#pragma unroll
        for (int r = 2; r < 16; r += 2) mx = __builtin_fmaxf(__builtin_fmaxf(mx, __builtin_fmaxf(p0[r], p1[r])), __builtin_fmaxf(p0[r + 1], p1[r + 1]));
        mx = fmaxf(mx, __shfl_xor(mx, 32));
        float alpha = 1.0f;
        const bool upd = __builtin_amdgcn_ballot_w64(mx > m_run + 8.0f) != 0ull;
        if (upd) { const float m_new = fmaxf(m_run, mx); alpha = __builtin_amdgcn_exp2f(m_run - m_new); m_run = m_new; }
        float rs = 0.f;
#pragma unroll
        for (int r = 0; r < 16; ++r) { p0[r] = __builtin_amdgcn_exp2f(p0[r] - m_run); p1[r] = __builtin_amdgcn_exp2f(p1[r] - m_run); rs += p0[r] + p1[r]; }
        l_run = l_run * alpha + rs;
        if (upd) {
          if (hi == 0) wsf[r32] = alpha;
#pragma unroll
          for (int g = 0; g < 4; ++g) { const f32x4 a4 = *(const ATT_LAS f32x4*)(wsf + 8 * g + 4 * hi);
#pragma unroll
            for (int c = 0; c < NC; ++c)
#pragma unroll
              for (int e = 0; e < 4; ++e) o[c][4 * g + e] *= a4[e]; }
        }
      } else {
        const bool full = (kv0 + 63 < qrow0);
        float l1a[16], l1b[16];
#pragma unroll
        for (int r = 0; r < 16; ++r) {
          const int kv = kv0 + (r & 3) + 8 * (r >> 2) + 4 * hi;
          { const float zc = __builtin_amdgcn_fmed3f(p0[r], -60.0f, 60.0f); const float E = __builtin_amdgcn_exp2f(zc); float om = __builtin_amdgcn_rcpf(1.0f + E); float b = E * om;
            if (!full && !(kv < t)) { om = 1.0f; b = 0.f; } l1a[r] = om; p0[r] = b; }
          { const float zc = __builtin_amdgcn_fmed3f(p1[r], -60.0f, 60.0f); const float E = __builtin_amdgcn_exp2f(zc); float om = __builtin_amdgcn_rcpf(1.0f + E); float b = E * om;
            if (!full && !(kv + 32 < t)) { om = 1.0f; b = 0.f; } l1b[r] = om; p1[r] = b; }
        }
        float SM[9], SP[9]; SM[8] = 1.0f; SP[8] = 1.0f;
#pragma unroll
        for (int g = 3; g >= 0; --g) SM[4 + g] = ((l1b[4 * g] * l1b[4 * g + 1]) * (l1b[4 * g + 2] * l1b[4 * g + 3])) * SM[5 + g];
#pragma unroll
        for (int g = 3; g >= 0; --g) SM[g] = ((l1a[4 * g] * l1a[4 * g + 1]) * (l1a[4 * g + 2] * l1a[4 * g + 3])) * SM[1 + g];
#pragma unroll
        for (int i2 = 0; i2 < 8; ++i2) SP[i2] = __shfl_xor(SM[i2], 32);
#pragma unroll
        for (int i2 = 0; i2 < 8; ++i2) {
          float later = carry * (SM[i2 + 1] * (hi ? SP[i2 + 1] : SP[i2]));
#pragma unroll
          for (int e = 3; e >= 0; --e) {
            const int r = 4 * (i2 & 3) + e;
            if (i2 >> 2) { p1[r] = p1[r] * later; later *= l1b[r]; } else { p0[r] = p0[r] * later; later *= l1a[r]; }
          }
        }
        carry *= SM[0] * SP[0];
        wdone = (__builtin_amdgcn_ballot_w64(carry != 0.0f) == 0ull);
      }
    }
    if (active) {
      pk[0] = (u32x4){cvtpk(p0[0], p0[1]), cvtpk(p0[2], p0[3]), cvtpk(p0[4], p0[5]), cvtpk(p0[6], p0[7])};
      pk[1] = (u32x4){cvtpk(p0[8], p0[9]), cvtpk(p0[10], p0[11]), cvtpk(p0[12], p0[13]), cvtpk(p0[14], p0[15])};
      pk[2] = (u32x4){cvtpk(p1[0], p1[1]), cvtpk(p1[2], p1[3]), cvtpk(p1[4], p1[5]), cvtpk(p1[6], p1[7])};
      pk[3] = (u32x4){cvtpk(p1[8], p1[9]), cvtpk(p1[10], p1[11]), cvtpk(p1[12], p1[13]), cvtpk(p1[14], p1[15])};
      if (lag) { pend = true; pvb = (unsigned)(vcur * VBUF); }
      else ATT_PV(lds + LDS_V + vcur * VBUF);
    }
    vcur = vnext;
    if (MODE == 0) { if (lane == 0) flags[(i & 1) * 8 + wid] = wdone ? 1u : 0u; }
    asm volatile("s_waitcnt vmcnt(0)" ::: "memory");
    __syncthreads();
    if (MODE == 0) {
      const u32x4 fa = *(const ATT_LAS u32x4*)(flags + (i & 1) * 8), fb = *(const ATT_LAS u32x4*)(flags + (i & 1) * 8 + 4);
      const unsigned all = fa[0] & fa[1] & fa[2] & fa[3] & fb[0] & fb[1] & fb[2] & fb[3];
      if (__builtin_amdgcn_readfirstlane(all) != 0u) break;
    }
  }
  if (lag && pend) ATT_PV(lds + LDS_V + pvb);
  if (MODE == 1) {
    const float l = l_run + __shfl_xor(l_run, 32);
    if (hi == 0) wsf[r32] = 1.0f / l;
    bf16_t* O = (bf16_t*)Op;
#pragma unroll
    for (int g = 0; g < 4; ++g) { const f32x4 i4 = *(const ATT_LAS f32x4*)(wsf + 8 * g + 4 * hi);
#pragma unroll
      for (int e = 0; e < 4; ++e) { bf16_t* orow = O + (size_t)(qrow0 + 8 * g + 4 * hi + e) * PITCH + r32;
#pragma unroll
        for (int c = 0; c < NC; ++c) orow[32 * c] = (bf16_t)(cvtpk(o[c][4 * g + e] * i4[e], 0.f) & 0xffffu); } }
  } else {
    bf16_t* O = (bf16_t*)Op;
#pragma unroll
    for (int g = 0; g < 4; ++g)
#pragma unroll
      for (int e = 0; e < 4; ++e) { bf16_t* orow = O + (size_t)(qrow0 + 8 * g + 4 * hi + e) * PITCH + r32;
#pragma unroll
        for (int c = 0; c < NC; ++c) orow[32 * c] = (bf16_t)(cvtpk(o[c][4 * g + e], 0.f) & 0xffffu); }
  }
  asm volatile("s_waitcnt lgkmcnt(0)\n\ts_barrier" ::: "memory");
}
#undef ATT_MFMA
#undef ATT_DMA
#undef ATT_PV
}
#define GAS __attribute__((address_space(1)))
#define LAS __attribute__((address_space(3)))
typedef unsigned short bf16;
typedef unsigned v4u __attribute__((ext_vector_type(4)));
typedef float f32x4 __attribute__((ext_vector_type(4)));
typedef short bf16x8 __attribute__((ext_vector_type(8)));
typedef GAS unsigned gu32;
typedef GAS unsigned long long gu64;
#define RLX_AGENT __ATOMIC_RELAXED, __HIP_MEMORY_SCOPE_AGENT
#define LDS_WAIT() asm volatile("s_waitcnt lgkmcnt(0)" ::: "memory")
#define VM_WAIT() asm volatile("s_waitcnt vmcnt(0)" ::: "memory")
__device__ __forceinline__ unsigned long long rt() { return __builtin_amdgcn_s_memrealtime(); }
__device__ __forceinline__ unsigned f2bf(float f) { unsigned u = __builtin_bit_cast(unsigned, f); return (u + 0x7fffu + ((u >> 16) & 1u)) >> 16; }
__device__ __forceinline__ unsigned pk2(float lo, float hi) { return f2bf(lo) | (f2bf(hi) << 16); }

#define XB_TMO      128
#define XB_XCNT(j)  (256  + 64 * (j))
#define XB_XSUB(j)  (1280 + 64 * (j))
#define XB_XGEN(j)  (2304 + 64 * (j))
#define XB_TOP      3328
#define XB_TOPGEN   3392
#define XCD_BAR_WORDS 3456
#define XB_SPIN_CAP (1u << 18)

__device__ __forceinline__ unsigned xb_ld(unsigned* p)              { return __hip_atomic_load(p, __ATOMIC_RELAXED, __HIP_MEMORY_SCOPE_AGENT); }
__device__ __forceinline__ unsigned xb_add(unsigned* p, unsigned v) { return __hip_atomic_fetch_add(p, v, __ATOMIC_RELAXED, __HIP_MEMORY_SCOPE_AGENT); }
__device__ __forceinline__ unsigned xb_xcc_id() { return (unsigned)__builtin_amdgcn_s_getreg((3 << 11) | 20) & 0xFu; }
#define XB_SPIN(cond, bar) do { unsigned _sp = 0; while (cond) { __builtin_amdgcn_s_sleep(1); \
    if ((++_sp & 255u) == 0u) { if (xb_ld(&(bar)[XB_TMO])) break; if (_sp > XB_SPIN_CAP) { atomicAdd(&(bar)[XB_TMO], 1u); break; } } } } while (0)

struct XcdBarrier {
    unsigned* bar; unsigned x;
    volatile LAS unsigned* st;
};

__device__ __forceinline__ XcdBarrier xcd_barrier_post(unsigned* bar, volatile LAS unsigned* st) {
    XcdBarrier b; b.bar = bar; b.x = xb_xcc_id(); b.st = st;
    if (threadIdx.x == 0) (void)xb_add(&bar[XB_XCNT(b.x)], 1u);
    return b;
}
__device__ __forceinline__ void xcd_barrier_complete(unsigned* bar, unsigned x, unsigned& nloc, unsigned& nx) {
    const unsigned G = gridDim.x * gridDim.y * gridDim.z;
    unsigned sum, cnt, mine, sp = 0u;
    for (;;) {
        sum = 0u; cnt = 0u; mine = 0u;
#pragma unroll
        for (unsigned j = 0; j < 16; ++j) { const unsigned c = xb_ld(&bar[XB_XCNT(j)]); sum += c; cnt += (c > 0u) ? 1u : 0u; mine = (j == x) ? c : mine; }
        if (sum == G) break;
        __builtin_amdgcn_s_sleep(1);
        if ((++sp & 255u) == 0u) { if (xb_ld(&bar[XB_TMO])) break; if (sp > XB_SPIN_CAP) { atomicAdd(&bar[XB_TMO], 1u); break; } }
    }
    nloc = mine > 0u ? mine : 1u; nx = cnt > 0u ? cnt : 1u;
}

__device__ __forceinline__ void xcd_barrier(const XcdBarrier& b) {
    asm volatile("s_waitcnt vmcnt(0)" ::: "memory");
    __syncthreads();
    if (threadIdx.x == 0) {
        unsigned* bar = b.bar;
        __builtin_amdgcn_s_waitcnt(0);
        unsigned nloc = b.st[0], nx = b.st[1];
        if (nloc == 0u) { xcd_barrier_complete(bar, b.x, nloc, nx); b.st[0] = nloc; b.st[1] = nx; }
        const unsigned old = xb_add(&bar[XB_XSUB(b.x)], 1u);
        const unsigned gen = old / nloc;
        if (old + 1u == (gen + 1u) * nloc) {
            __builtin_amdgcn_fence(__ATOMIC_RELEASE, "agent");
            asm volatile("s_waitcnt vmcnt(0)" ::: "memory");
            const unsigned og = xb_add(&bar[XB_TOP], 1u);
            const unsigned tg = og / nx;
            if (og + 1u == (tg + 1u) * nx) xb_add(&bar[XB_TOPGEN], 1u);
            else XB_SPIN(xb_ld(&bar[XB_TOPGEN]) == tg, bar);
            __builtin_amdgcn_fence(__ATOMIC_ACQUIRE, "agent");
            xb_add(&bar[XB_XGEN(b.x)], 1u);
            asm volatile("s_waitcnt vmcnt(0)" ::: "memory");
        } else {
            XB_SPIN(xb_ld(&bar[XB_XGEN(b.x)]) == gen, bar);
            __builtin_amdgcn_fence(__ATOMIC_ACQUIRE, "agent");
            asm volatile("s_waitcnt vmcnt(0)" ::: "memory");
        }
    }
    __syncthreads();
}
constexpr int NWAVES = 8;
constexpr int BATCH = 2, SEQ = 4096, D = 2048, M = BATCH * SEQ, FF = 5632, NPROJ = 6144;
constexpr float EPS = 1e-6f;
constexpr float C2 = 0.08838834764831845f * 1.4426950408889634f;
constexpr float LAMBDA_INIT = 0.35550906759f;
constexpr size_t MiB = 1u << 20;
constexpr size_t WS_CTL = 0, CTL_ZERO_BYTES = 65536 + 3 * 65536;
constexpr size_t WS_SS = 65536;
constexpr size_t WS_ROPE = 1 * MiB;
constexpr size_t WS_WKVQ = 4 * MiB, WS_WO_B = 28 * MiB, WS_WGU_B = 36 * MiB, WS_WD_B = 80 * MiB;
constexpr size_t WS_AB = 102 * MiB;
constexpr size_t WS_P0 = 134 * MiB, WS_P1 = 166 * MiB, WS_P2 = 198 * MiB;
constexpr size_t WS_ACT = 230 * MiB;
constexpr size_t WS_WQKV_A = 318 * MiB, WS_WO_A = 342 * MiB, WS_WGU_A = 350 * MiB, WS_WD_A = 394 * MiB;
constexpr size_t WS_OB = 318 * MiB;
constexpr size_t WS_XB = 416 * MiB;
constexpr size_t WS_END = 448 * MiB;
constexpr int CW_BAR = 1024;
constexpr int RING_BYTES = 131072, LDSCTL_OFF = RING_BYTES, MISC_OFF = LDSCTL_OFF + 320, LDS_BYTES = 147456;
static_assert(att::LDS_BYTES <= LDS_BYTES && att::LDS_WS >= MISC_OFF + 128 && (2 + 3 * 2) * att::TILE_BYTES <= RING_BYTES && (3 + 4) * att::TILE_BYTES <= RING_BYTES, "attention LDS");

__device__ __forceinline__ float wave_sum(float v) {
#pragma unroll
    for (int o = 1; o < 64; o <<= 1) v += __shfl_xor(v, o);
    return v;
}
__device__ __forceinline__ void transpose_item(const float* __restrict__ W, int K, int N, bf16* WT, int row_off, int gu_map, const float* __restrict__ gain, LAS float* scr, int item, int lane) {
    const int nblk = N / 32, kb = item / nblk, nb = item - kb * nblk, k0 = 64 * kb, n0 = 32 * nb;
    float wv[32];
#pragma unroll
    for (int i = 0; i < 32; ++i) { const int kk = 2 * i + (lane >> 5); wv[i] = __builtin_nontemporal_load(W + (size_t)(k0 + kk) * N + n0 + (lane & 31)); }
    if (gain) {
#pragma unroll
        for (int i = 0; i < 32; ++i) wv[i] *= gain[k0 + 2 * i + (lane >> 5)];
    }
#pragma unroll
    for (int i = 0; i < 32; ++i) scr[(2 * i + (lane >> 5)) * 33 + (lane & 31)] = wv[i];
    LDS_WAIT(); asm volatile("" ::: "memory");
    int drow0 = row_off + n0;
    if (gu_map) { const int half = N / 2, isup = n0 >= half ? 1 : 0, j = n0 - isup * half; drow0 = 256 * (j >> 7) + 128 * isup + (j & 127); }
    const int c = lane & 7;
#pragma unroll
    for (int j = 0; j < 4; ++j) { const int n = (lane >> 3) + 8 * j; const LAS float* s = scr + (8 * c) * 33 + n;
        v4u o; o.x = pk2(s[0 * 33], s[1 * 33]); o.y = pk2(s[2 * 33], s[3 * 33]); o.z = pk2(s[4 * 33], s[5 * 33]); o.w = pk2(s[6 * 33], s[7 * 33]);
        *(GAS v4u*)(WT + (size_t)(drow0 + n) * K + k0 + 8 * c) = o; }
    LDS_WAIT(); asm volatile("" ::: "memory");
}
__device__ __forceinline__ void xb_rows(const float* X, bf16* out, unsigned long long* ss, int gw, int NGW, int lane) {
    for (int m = gw; m < M; m += NGW) {
        const GAS f32x4* xr = (const GAS f32x4*)(X + (size_t)m * D) + lane;
        f32x4 v[8]; float s = 0.f;
#pragma unroll
        for (int j = 0; j < 8; ++j) { v[j] = xr[64 * j]; s += (v[j].x * v[j].x + v[j].y * v[j].y) + (v[j].z * v[j].z + v[j].w * v[j].w); }
        s = wave_sum(s);
        if (lane == 0) ss[m] = (unsigned long long)(s * 16777216.0f);
        GAS unsigned long long* o8 = (GAS unsigned long long*)(out + (size_t)m * D) + lane;
#pragma unroll
        for (int j = 0; j < 8; ++j) o8[64 * j] = (unsigned long long)pk2(v[j].x, v[j].y) | ((unsigned long long)pk2(v[j].z, v[j].w) << 32);
    }
}
__device__ __forceinline__ void rms_rows(const float* X, bf16* out, int gw, int NGW, int lane) {
    for (int m = gw; m < M; m += NGW) {
        const GAS f32x4* xr = (const GAS f32x4*)(X + (size_t)m * D) + lane;
        f32x4 v[8]; float s = 0.f;
#pragma unroll
        for (int j = 0; j < 8; ++j) { v[j] = xr[64 * j]; s += (v[j].x * v[j].x + v[j].y * v[j].y) + (v[j].z * v[j].z + v[j].w * v[j].w); }
        const float r = 1.0f / sqrtf(wave_sum(s) * (1.0f / D) + EPS);
        GAS unsigned long long* o8 = (GAS unsigned long long*)(out + (size_t)m * D) + lane;
#pragma unroll
        for (int j = 0; j < 8; ++j) o8[64 * j] = (unsigned long long)pk2(v[j].x * r, v[j].y * r) | ((unsigned long long)pk2(v[j].z * r, v[j].w * r) << 32);
    }
}
__device__ __forceinline__ float bf2f(unsigned short h) { return __uint_as_float(((unsigned)h) << 16); }
__device__ __forceinline__ void qknorm_rope_row(bf16* row, const float* __restrict__ gain, float sc, const float* __restrict__ cs  , int lane) {
    const int cc = lane & 7;
    float ga[8], gb[8], co[8], si[8];
#pragma unroll
    for (int e = 0; e < 8; ++e) { ga[e] = gain[8 * cc + e]; gb[e] = gain[64 + 8 * cc + e]; co[e] = cs[2 * (8 * cc + e)]; si[e] = cs[2 * (8 * cc + e) + 1]; }
#pragma unroll
    for (int it = 0; it < 2; ++it) {
        bf16* p = row + 128 * (8 * it + (lane >> 3)) + 8 * cc;
        const v4u a = *(const GAS v4u*)p, b = *(const GAS v4u*)(p + 64);
        float xa[8], xb[8]; float ss = 0.f;
#pragma unroll
        for (int e = 0; e < 4; ++e) { xa[2 * e] = __uint_as_float(a[e] << 16); xa[2 * e + 1] = __uint_as_float(a[e] & 0xffff0000u); xb[2 * e] = __uint_as_float(b[e] << 16); xb[2 * e + 1] = __uint_as_float(b[e] & 0xffff0000u); }
#pragma unroll
        for (int e = 0; e < 8; ++e) ss += xa[e] * xa[e] + xb[e] * xb[e];
        ss += __shfl_xor(ss, 1); ss += __shfl_xor(ss, 2); ss += __shfl_xor(ss, 4);
        const float r = 1.0f / sqrtf(ss * (1.0f / 128.0f) + EPS);
        float oa[8], ob[8];
#pragma unroll
        for (int e = 0; e < 8; ++e) { const float ya = xa[e] * r * ga[e], yb = xb[e] * r * gb[e]; oa[e] = (ya * co[e] - yb * si[e]) * sc; ob[e] = (yb * co[e] + ya * si[e]) * sc; }
        v4u wa, wb;
#pragma unroll
        for (int e = 0; e < 4; ++e) { wa[e] = pk2(oa[2 * e], oa[2 * e + 1]); wb[e] = pk2(ob[2 * e], ob[2 * e + 1]); }
        *(GAS v4u*)p = wa; *(GAS v4u*)(p + 64) = wb;
    }
}

struct Args { const float* in[22]; float* out; unsigned char* ws; };
typedef __attribute__((address_space(4))) const Args* ArgsCP;
__device__ __forceinline__ ArgsCP argp() { ArgsCP p = (ArgsCP)__builtin_amdgcn_kernarg_segment_ptr(); asm volatile("" : "+s"(p)); return p; }


#ifndef MK_CG_ALL
#define MK_CG_ALL 0
#endif
#if MK_CG_ALL
#define GSYNC() cg::this_grid().sync()
#else
#define GSYNC() do { XcdBarrier b_; b_.bar = (unsigned*)((gu32*)(argp()->ws + WS_CTL) + CW_BAR); b_.x = xb_xcc_id(); b_.st = (volatile LAS unsigned*)(lds + MISC_OFF) + 8; xcd_barrier(b_); } while (0)
#endif
__device__ __forceinline__ int opaque_tid() { int t = threadIdx.x; asm volatile("" : "+v"(t)); return t; }
namespace att {
__device__ __forceinline__ const float* att_qgain() { return argp()->in[12]; }
__device__ __forceinline__ const float* att_rope() { return (const float*)(argp()->ws + WS_ROPE); }
}
template <int L>
__device__ __forceinline__ void layer_body(LAS unsigned char* lds, unsigned char* ws, const float* x, float* out,
                                           int G, int bx, int vcu, int gw, int NGW) {
    bf16* AB = (bf16*)(ws + WS_AB); bf16* P0 = (bf16*)(ws + WS_P0); bf16* P1 = (bf16*)(ws + WS_P1); bf16* P2 = (bf16*)(ws + WS_P2);
    bf16* ACT = (bf16*)(ws + WS_ACT); bf16* OB = (bf16*)(ws + WS_OB); float* ROPE = (float*)(ws + WS_ROPE);
        bf16* XB = (bf16*)(ws + WS_XB); unsigned long long* SS = (unsigned long long*)(ws + WS_SS);
        {
            pg8::Gemm g{XB, (const bf16*)(ws + (L == 0 ? WS_WQKV_A : WS_WKVQ)), M, NPROJ, D}; pg8::StaticOrder S; S.init(M, NPROJ, G, bx);
            pg8::EpiProj E{P0, D, D, (size_t)(WS_P1 - WS_P0) / 2, L == 0 ? C2 : 1.0f, L == 0 ? SS + 3 * (size_t)M : SS + M, (1.0f / D) * (1.0f / 16777216.0f), EPS};
            pg8::gemm_phase<pg8::EpiProj, pg8::StaticOrder, true, true>(lds, g, S, E);
        }
        GSYNC();
        if constexpr (L == 0) {
            constexpr int TOTAL = 32 * 16; const int per = (TOTAL + G - 1) / G;
            for (int idx = vcu * per; idx < (vcu + 1) * per && idx < TOTAL; ++idx) {
                const int hp = idx >> 4, k = idx & 15, qb = (k & 1) ? 15 - (k >> 1) : (k >> 1);
                const size_t base = (size_t)(hp >> 4) * SEQ * D + 128 * (hp & 15);
                att::attn_unit<0, 4>(lds, P0 + base, P1 + base, P2 + base, (void*)(AB + base), qb * att::QB);
            }
            GSYNC();
        } else {
            const int lane = opaque_tid() & 63;
            for (int m = gw; m < M; m += NGW) qknorm_rope_row(P0 + (size_t)m * D, argp()->in[9], 1.0f, ROPE + (size_t)(m & (SEQ - 1)) * 128, lane);
            GSYNC();
            constexpr int TOTAL = 32 * 16; const int per = (TOTAL + G - 1) / G;
            for (int idx = vcu * per; idx < (vcu + 1) * per && idx < TOTAL; ++idx) {
                const int hp = idx >> 4, k = idx & 15, qb = (k & 1) ? 15 - (k >> 1) : (k >> 1);
                const int c = hp & 1, h = (hp >> 1) & 7, b = hp >> 4;
                const size_t rb = (size_t)b * SEQ * D;
                att::attn_unit<1, 8, true>(lds, P2 + rb + (2 * h + c) * 128, P0 + rb + (2 * h + c) * 128, P1 + rb + 256 * h, (void*)(OB + (size_t)c * M * D + rb + 256 * h), qb * att::QB);
            }
            GSYNC();
            {
                const int lane = opaque_tid() & 63;
                const float a1 = argp()->in[13][lane] * argp()->in[14][lane] + argp()->in[13][lane + 64] * argp()->in[14][lane + 64];
                const float a2 = argp()->in[15][lane] * argp()->in[16][lane] + argp()->in[15][lane + 64] * argp()->in[16][lane + 64];
                const float lam = expf(wave_sum(a1)) - expf(wave_sum(a2)) + LAMBDA_INIT;
                const f32x4 gs = *(const GAS f32x4*)(argp()->in[17] + 4 * lane);
                for (int m = gw; m < M; m += NGW) {
#pragma unroll
                    for (int h = 0; h < 8; ++h) {
                        const size_t off = (size_t)m * D + 256 * h + 4 * lane;
                        const unsigned long long w0 = *(const GAS unsigned long long*)(OB + off), w1 = *(const GAS unsigned long long*)(OB + (size_t)M * D + off);
                        const f32x4 o0 = {__uint_as_float((unsigned)w0 << 16), __uint_as_float((unsigned)w0 & 0xffff0000u), __uint_as_float((unsigned)(w0 >> 32) << 16), __uint_as_float((unsigned)(w0 >> 32) & 0xffff0000u)};
                        const f32x4 o1 = {__uint_as_float((unsigned)w1 << 16), __uint_as_float((unsigned)w1 & 0xffff0000u), __uint_as_float((unsigned)(w1 >> 32) << 16), __uint_as_float((unsigned)(w1 >> 32) & 0xffff0000u)};
                        const f32x4 o = o0 - lam * o1;
                        const float ss = wave_sum((o.x * o.x + o.y * o.y) + (o.z * o.z + o.w * o.w));
                        const float r = (1.0f - LAMBDA_INIT) / sqrtf(ss * (1.0f / 256.0f) + EPS);
                        *(GAS unsigned long long*)(AB + off) = (unsigned long long)pk2(o.x * r * gs.x, o.y * r * gs.y) | ((unsigned long long)pk2(o.z * r * gs.z, o.w * r * gs.w) << 32);
                    }
                }
            }
            GSYNC();
        }
        {
            pg8::Gemm g{AB, (const bf16*)(ws + (L == 0 ? WS_WO_A : WS_WO_B)), M, D, D}; pg8::StaticOrder S; S.init(M, D, G, bx);
            { pg8::EpiRes2<true, false, true> E{(const void*)XB, nullptr, XB, SS + (L == 0 ? 0 : 2 * M), D}; pg8::gemm_phase<pg8::EpiRes2<true, false, true>, pg8::StaticOrder, true, true>(lds, g, S, E); }
        }
        GSYNC();
        {
            pg8::Gemm g{XB, (const bf16*)(ws + (L == 0 ? WS_WGU_A : WS_WGU_B)), M, 2 * FF, D}; pg8::StaticOrder S; S.init(M, 2 * FF, G, bx);
            pg8::EpiSwiglu E{ACT, FF, SS + (L == 0 ? 0 : 2 * M), (1.0f / D) * (1.0f / 16777216.0f), EPS};
            pg8::gemm_phase<pg8::EpiSwiglu, pg8::StaticOrder, true, true>(lds, g, S, E);
            if constexpr (L == 0) {
                if (G == 256 && bx >= 128) {
                    const int t_ = opaque_tid(), lane = t_ & 63, wave = __builtin_amdgcn_readfirstlane(t_ >> 6);
                    LAS float* scr = (LAS float*)(lds + wave * 16384);
                    for (int it = (bx - 128) * NWAVES + wave; it < 32 * 352; it += 128 * NWAVES) transpose_item(argp()->in[20], D, 2 * FF, (bf16*)(ws + WS_WGU_B), 0, 1, argp()->in[19], scr, it, lane);
                }
            } else {
                if (G == 256 && bx >= 128) {
                    const int t_ = opaque_tid(), lane = t_ & 63, wave = __builtin_amdgcn_readfirstlane(t_ >> 6);
                    LAS float* scr = (LAS float*)(lds + wave * 16384);
                    for (int it = (bx - 128) * NWAVES + wave; it < 88 * 64; it += 128 * NWAVES) transpose_item(argp()->in[21], FF, D, (bf16*)(ws + WS_WD_B), 0, 0, nullptr, scr, it, lane);
                }
            }
        }
        GSYNC();
        {
            pg8::Gemm g{ACT, (const bf16*)(ws + (L == 0 ? WS_WD_A : WS_WD_B)), M, D, FF}; pg8::StaticOrder S; S.init(M, D, G, bx);
            if constexpr (L == 0) { pg8::EpiRes2<true, false, true> E{(const void*)XB, nullptr, XB, SS + M, D}; pg8::gemm_phase<pg8::EpiRes2<true, false, true>, pg8::StaticOrder, true, true>(lds, g, S, E); }
            else { pg8::EpiRes2<true, true, false> E{(const void*)XB, out, nullptr, nullptr, D}; pg8::gemm_phase<pg8::EpiRes2<true, true, false>, pg8::StaticOrder, true, true>(lds, g, S, E); }
        }
        if (L == 0) GSYNC();
}

__global__ void __launch_bounds__(NWAVES * 64, 2) fwd_megakernel(Args args) {
    extern __shared__ __attribute__((aligned(16))) unsigned char lds_raw[];
    LAS unsigned char* lds = (LAS unsigned char*)lds_raw;
    volatile LAS unsigned* MISC = (volatile LAS unsigned*)(lds + MISC_OFF);
    const int tid = threadIdx.x, lane = tid & 63, wave = __builtin_amdgcn_readfirstlane(tid >> 6);
    const int G = gridDim.x; const int bx = blockIdx.x;
    const int vcu = (G % 8 == 0) ? (bx % 8) * (G / 8) + bx / 8 : bx;
    const int gw = vcu * NWAVES + wave, NGW = G * NWAVES;
    unsigned char* ws = argp()->ws;
    gu32* ctl = (gu32*)(ws + WS_CTL);
    const float* x = argp()->in[0]; float* out = argp()->out;
    bf16* AB = (bf16*)(ws + WS_AB); bf16* P0 = (bf16*)(ws + WS_P0); bf16* P1 = (bf16*)(ws + WS_P1); bf16* P2 = (bf16*)(ws + WS_P2);
    bf16* ACT = (bf16*)(ws + WS_ACT); bf16* OB = (bf16*)(ws + WS_OB); float* ROPE = (float*)(ws + WS_ROPE);
    for (int u = tid; u < (LDS_BYTES - LDSCTL_OFF) / 4; u += NWAVES * 64) ((LAS unsigned*)(lds + LDSCTL_OFF))[u] = 0u;
    __syncthreads();
    for (unsigned u = (unsigned)(bx * NWAVES * 64 + tid); u < CTL_ZERO_BYTES / 4; u += (unsigned)(G * NWAVES * 64)) ctl[u] = 0u;


    {
        LAS float* scr = (LAS float*)(lds + wave * 16384);
        constexpr int I_QKV = 32 * 192, I_O = 32 * 64, I_GU = 32 * 352, I_D = 88 * 64, I_KV = 32 * 128;
        constexpr int NITEMS = I_QKV + 3 * I_O + 2 * I_GU + 2 * I_D + I_KV;
        for (int it = gw; it < NITEMS; it += NGW) {
            int r = it;
            if (r < I_QKV) { transpose_item(argp()->in[2], D, NPROJ, (bf16*)(ws + WS_WQKV_A), 0, 0, argp()->in[1], scr, r, lane); continue; } r -= I_QKV;
            if (r < I_O)   { transpose_item(argp()->in[3], D, D, (bf16*)(ws + WS_WO_A), 0, 0, nullptr, scr, r, lane); continue; } r -= I_O;
            if (r < I_GU)  { transpose_item(argp()->in[5], D, 2 * FF, (bf16*)(ws + WS_WGU_A), 0, 1, argp()->in[4], scr, r, lane); continue; } r -= I_GU;
            if (r < I_D)   { transpose_item(argp()->in[6], FF, D, (bf16*)(ws + WS_WD_A), 0, 0, nullptr, scr, r, lane); continue; } r -= I_D;
            if (r < I_KV)  { transpose_item(argp()->in[8], D, 2 * D, (bf16*)(ws + WS_WKVQ), 0, 0, argp()->in[7], scr, r, lane); continue; } r -= I_KV;
            if (r < I_O)   { transpose_item(argp()->in[11], D, D, (bf16*)(ws + WS_WKVQ), 2 * D, 0, argp()->in[10], scr, r, lane); continue; } r -= I_O;
            if (r < I_O)   { transpose_item(argp()->in[18], D, D, (bf16*)(ws + WS_WO_B), 0, 0, nullptr, scr, r, lane); continue; } r -= I_O;
            if (r < I_GU)  { if (G != 256) transpose_item(argp()->in[20], D, 2 * FF, (bf16*)(ws + WS_WGU_B), 0, 1, argp()->in[19], scr, r, lane); continue; } r -= I_GU;
            if (G != 256) transpose_item(argp()->in[21], FF, D, (bf16*)(ws + WS_WD_B), 0, 0, nullptr, scr, r, lane);
        }
        xb_rows(x, (bf16*)(ws + WS_XB), (unsigned long long*)(ws + WS_SS) + 3 * (size_t)M, gw, NGW, lane);
        for (int e = (vcu * NWAVES * 64 + tid); e < SEQ * 64; e += G * NWAVES * 64) {
            const int pos = e >> 6, i = e & 63;
            const float inv_freq = powf(10000.0f, -(float)i * (1.0f / 64.0f));
            const float ang = (float)pos * inv_freq;
            const double rev = (double)ang * 0.15915494309189535;
            const float fr = (float)(rev - __builtin_rint(rev));
            ROPE[2 * e] = __builtin_amdgcn_cosf(fr); ROPE[2 * e + 1] = __builtin_amdgcn_sinf(fr);
        }
    }
    cg::this_grid().sync();
    (void)xcd_barrier_post((unsigned*)(ctl + CW_BAR), MISC + 8);

    layer_body<0>(lds, ws, x, out, G, bx, vcu, gw, NGW);
    layer_body<1>(lds, ws, x, out, G, bx, vcu, gw, NGW);
}

extern "C" void kernel_launch(void* const* d_in, const int* in_sizes, int n_in, void* d_out, int out_size, void* d_ws, size_t ws_size, hipStream_t stream) {
    static int grid = 0;
    if (grid == 0) {
        if (n_in != 22 || in_sizes[0] != M * D || out_size != M * D || ws_size < WS_END) { fprintf(stderr, "kernel_launch: unexpected problem shape / workspace (n_in %d, in0 %d, out %d, ws %zu)\n", n_in, n_in > 0 ? in_sizes[0] : -1, out_size, ws_size); grid = -1; return; }
        int dev = 0, cus = 0, per_cu = 0;
        if (hipGetDevice(&dev) != hipSuccess || hipDeviceGetAttribute(&cus, hipDeviceAttributeMultiprocessorCount, dev) != hipSuccess) { grid = -1; return; }
        if (hipFuncSetAttribute((const void*)fwd_megakernel, hipFuncAttributeMaxDynamicSharedMemorySize, LDS_BYTES) != hipSuccess) { fprintf(stderr, "kernel_launch: hipFuncSetAttribute failed\n"); grid = -1; return; }
        if (hipOccupancyMaxActiveBlocksPerMultiprocessor(&per_cu, (const void*)fwd_megakernel, NWAVES * 64, LDS_BYTES) != hipSuccess || per_cu < 1) { fprintf(stderr, "kernel_launch: occupancy query says %d blocks per CU\n", per_cu); (void)hipGetLastError(); per_cu = 1; }
        grid = cus;
    }
    if (grid < 0) return;
    Args a{};
    for (int i = 0; i < 22; ++i) a.in[i] = (const float*)d_in[i];
    a.out = (float*)d_out; a.ws = (unsigned char*)d_ws;
    void* kargs[] = {&a};
    const hipError_t e = hipLaunchCooperativeKernel((const void*)fwd_megakernel, dim3(grid), dim3(NWAVES * 64), kargs, LDS_BYTES, stream);
    if (e != hipSuccess) fprintf(stderr, "kernel_launch: cooperative launch failed: %s (grid %d)\n", hipGetErrorString(e), grid);
}
```

```cpp
#include <hip/hip_runtime.h>
#include <hip/hip_cooperative_groups.h>
#include <cstdio>
#include <cstdint>
#include <cmath>
namespace cg = cooperative_groups;
namespace pg8 {
#define PG8_LAS __attribute__((address_space(3)))
typedef unsigned short bf16_t;
typedef short bf16x8 __attribute__((ext_vector_type(8)));
typedef float f32x4 __attribute__((ext_vector_type(4)));
typedef unsigned u32x4 __attribute__((ext_vector_type(4)));
constexpr int BM = 256, BK = 64, HALF = 128, HTB = HALF * BK * 2  , STAGE_BYTES = 8 * HTB, NXCD = 8, WGM = 8;

__host__ __device__ __forceinline__ int lds_byte(int r, int c) { const int st = (r >> 4) * 2 + (c >> 5), rr = r & 15, cc = c & 31, ob = rr * 64 + cc * 2; return st * 1024 + (ob ^ (((ob >> 9) & 1) << 5)); }
__host__ __device__ __forceinline__ void stage_rc(int b, int& R, int& C) { const int st = b / 1024, sb = b % 1024, swz = sb ^ (((sb >> 9) & 1) << 5); R = (st >> 1) * 16 + swz / 64; C = (st & 1) * 32 + (swz % 64) / 2; }
__host__ __device__ __forceinline__ int perm32(int rho) { const int n = rho >> 4, i = rho & 15; return 8 * (i >> 2) + 4 * n + (i & 3); }

struct Unit { int pm, pn; };
struct Gemm { const bf16_t* A; const bf16_t* Bt; int M, N, K; };

struct StaticOrder {
    int nM, nN, nwg, G, c;
    __host__ __device__ void init(int M, int N, int G_, int c_) { nM = M / BM; nN = N / BM; nwg = nM * nN; G = G_; c = c_; }
    __host__ __device__ bool next(int i, Unit& u) const {
        const long L = (long)i * G + c; if (L >= nwg) return false;
        int wgid = (int)L; { const int q = nwg / NXCD, r = nwg % NXCD, xcd = wgid % NXCD, off = wgid / NXCD; wgid = (xcd < r ? xcd * (q + 1) : r * (q + 1) + (xcd - r) * q) + off; }
        const int nig = WGM * nN, gid = wgid / nig, fm = gid * WGM, gsz = (nM - fm) < WGM ? (nM - fm) : WGM;
        u.pm = fm + ((wgid % nig) % gsz); u.pn = (wgid % nig) / gsz; return true;
    }
    __device__ __forceinline__ void a_ready(const Unit&) const {}
    __device__ __forceinline__ void done(const Unit&) const {}
};

__device__ __forceinline__ unsigned cvt_pk_bf16(float lo, float hi) { unsigned r; asm volatile("v_cvt_pk_bf16_f32 %0, %1, %2" : "=v"(r) : "v"(lo), "v"(hi)); return r; }
typedef float f32x2 __attribute__((ext_vector_type(2)));
__device__ __forceinline__ f32x2 gelu_pk(f32x2 v) {
    const f32x2 av = __builtin_elementwise_abs(v), d = av * 0.2316418882f + 1.0f;
    f32x2 t; t.x = __builtin_amdgcn_rcpf(d.x); t.y = __builtin_amdgcn_rcpf(d.y);
    f32x2 q = t * 0.5307027145f + (-0.7265760135f); q = q * t + 0.7107068705f; q = q * t + (-0.142248368f); q = q * t + 0.127414796f; q = q * t;
    const f32x2 s = (v * v) * (-0.72134752044f);
    f32x2 e; e.x = __builtin_amdgcn_exp2f(s.x); e.y = __builtin_amdgcn_exp2f(s.y);
    const f32x2 m = v * (q * e), r = v - m;
    f32x2 o; o.x = v.x < 0.f ? m.x : r.x; o.y = v.y < 0.f ? m.y : r.y; return o;
}

template <int ACT  > struct EpiBf16 {
    static constexpr bool PERM = true, AFTER_DRAIN = false; static_assert(ACT == 0 || ACT == 1, "EpiBf16: ACT is 0 (none) or 1 (gelu_pk)");
    bf16_t* O; int ldc; const float* bias; int split_cols; size_t split_stride; float scale0;
    __device__ __forceinline__ void operator()(const f32x4 (&acc)[2][2][4][2], const Unit& u, int wr, int wc, int fr, int fq) const {
        const int row0 = u.pm * BM + wr * 64 + fr; int colt = u.pn * BM; bf16_t* base = O;
        float sc = 1.f; if (split_cols) { const int t = colt / split_cols; base += (size_t)t * split_stride; colt -= t * split_cols; if (t == 0) sc = scale0; }
        const int col0 = colt + wc * 32 + 8 * fq, bcol0 = u.pn * BM + wc * 32 + 8 * fq;
        f32x4 bv[2][2];
#pragma unroll
        for (int bj = 0; bj < 2; ++bj)
#pragma unroll
            for (int n = 0; n < 2; ++n) bv[bj][n] = bias ? *(const f32x4*)(bias + bcol0 + bj * HALF + 4 * n) : (f32x4){0.f, 0.f, 0.f, 0.f};
#pragma unroll
        for (int ai = 0; ai < 2; ++ai)
#pragma unroll
            for (int m = 0; m < 4; ++m) { bf16_t* rowp = base + (size_t)(row0 + ai * HALF + m * 16) * ldc + col0;
#pragma unroll
                for (int bj = 0; bj < 2; ++bj) { f32x4 v0 = acc[ai][bj][m][0] + bv[bj][0], v1 = acc[ai][bj][m][1] + bv[bj][1];
                    if (ACT == 1) { f32x2 a = gelu_pk((f32x2){v0[0], v0[1]}), b = gelu_pk((f32x2){v0[2], v0[3]}), c = gelu_pk((f32x2){v1[0], v1[1]}), d = gelu_pk((f32x2){v1[2], v1[3]});
                        v0 = (f32x4){a.x, a.y, b.x, b.y}; v1 = (f32x4){c.x, c.y, d.x, d.y}; }
                    v0 = v0 * sc; v1 = v1 * sc; u32x4 w; w.x = cvt_pk_bf16(v0[0], v0[1]); w.y = cvt_pk_bf16(v0[2], v0[3]); w.z = cvt_pk_bf16(v1[0], v1[1]); w.w = cvt_pk_bf16(v1[2], v1[3]);
                    *(u32x4*)(rowp + bj * HALF) = w; } }
    }
};
struct EpiRes {
    static constexpr bool PERM = false, AFTER_DRAIN = false;
    const float* base; float* out; int ldc;
    __device__ __forceinline__ void operator()(const f32x4 (&acc)[2][2][4][2], const Unit& u, int wr, int wc, int fr, int fq) const {
        const int row0 = u.pm * BM + wr * 64 + fr, col0 = u.pn * BM + wc * 32 + 4 * fq;
#pragma unroll
        for (int ai = 0; ai < 2; ++ai)
#pragma unroll
            for (int m = 0; m < 4; ++m) { const size_t off = (size_t)(row0 + ai * HALF + m * 16) * ldc + col0;
#pragma unroll
                for (int bj = 0; bj < 2; ++bj)
#pragma unroll
                    for (int n = 0; n < 2; ++n) { const f32x4 b = *(const f32x4*)(base + off + bj * HALF + n * 16); *(f32x4*)(out + off + bj * HALF + n * 16) = b + acc[ai][bj][m][n]; }  asm volatile("" ::: "memory"); }
    }
};
struct EpiSwiglu {
    static constexpr bool PERM = true, AFTER_DRAIN = false;
    bf16_t* O; int ldo; const unsigned long long* ss; float inv_d, eps;
    static __device__ __forceinline__ float sg(float g, float u) { return g * u * __builtin_amdgcn_rcpf(1.0f + __builtin_amdgcn_exp2f(-1.4426950408889634f * g)); }
    __device__ __forceinline__ void operator()(const f32x4 (&acc)[2][2][4][2], const Unit& u, int wr, int wc, int fr, int fq) const {
        const int row0 = u.pm * BM + wr * 64 + fr, col0 = u.pn * HALF + wc * 32 + 8 * fq;
#pragma unroll
        for (int ai = 0; ai < 2; ++ai)
#pragma unroll
            for (int m = 0; m < 4; ++m) { const int row = row0 + ai * HALF + m * 16; bf16_t* rowp = O + (size_t)row * ldo + col0;
                const float r = __builtin_amdgcn_rsqf((float)ss[row] * inv_d + eps);
                const float a = -1.4426950408889634f * r, r2 = r * r;
                f32x4 o4[2];
#pragma unroll
                for (int n = 0; n < 2; ++n) { const f32x4 g = acc[ai][0][m][n], uu = acc[ai][1][m][n]; const f32x4 t = g * a;
                    f32x4 d; d[0] = __builtin_amdgcn_exp2f(t[0]); d[1] = __builtin_amdgcn_exp2f(t[1]); d[2] = __builtin_amdgcn_exp2f(t[2]); d[3] = __builtin_amdgcn_exp2f(t[3]);
                    d = d + 1.0f;
                    f32x4 iv; iv[0] = __builtin_amdgcn_rcpf(d[0]); iv[1] = __builtin_amdgcn_rcpf(d[1]); iv[2] = __builtin_amdgcn_rcpf(d[2]); iv[3] = __builtin_amdgcn_rcpf(d[3]);
                    o4[n] = (g * uu) * (iv * r2); }
                u32x4 w; w.x = cvt_pk_bf16(o4[0][0], o4[0][1]); w.y = cvt_pk_bf16(o4[0][2], o4[0][3]); w.z = cvt_pk_bf16(o4[1][0], o4[1][1]); w.w = cvt_pk_bf16(o4[1][2], o4[1][3]);
                *(u32x4*)rowp = w; }
    }
};


struct EpiResNorm {
    static constexpr bool PERM = false, AFTER_DRAIN = false;
    const float* base; float* out; bf16_t* xb; float* ss; int ldc;
    __device__ __forceinline__ void operator()(const f32x4 (&acc)[2][2][4][2], const Unit& u, int wr, int wc, int fr, int fq) const {
        const int row0 = u.pm * BM + wr * 64 + fr, col0 = u.pn * BM + wc * 32 + 4 * fq;
#pragma unroll
        for (int ai = 0; ai < 2; ++ai)
#pragma unroll
            for (int m = 0; m < 4; ++m) { const int row = row0 + ai * HALF + m * 16; const size_t off = (size_t)row * ldc + col0; float s = 0.f;
#pragma unroll
                for (int bj = 0; bj < 2; ++bj)
#pragma unroll
                    for (int n = 0; n < 2; ++n) { const f32x4 b = *(const f32x4*)(base + off + bj * HALF + n * 16); const f32x4 v = b + acc[ai][bj][m][n]; *(f32x4*)(out + off + bj * HALF + n * 16) = v;
                        s += (v[0] * v[0] + v[1] * v[1]) + (v[2] * v[2] + v[3] * v[3]);
                        unsigned long long w = (unsigned long long)cvt_pk_bf16(v[0], v[1]) | ((unsigned long long)cvt_pk_bf16(v[2], v[3]) << 32);
                        *(unsigned long long*)(xb + off + bj * HALF + n * 16) = w; }
                s += __shfl_xor(s, 16); s += __shfl_xor(s, 32);
                if (fq == 0) atomicAdd(ss + row, s);
                asm volatile("" ::: "memory"); }
    }
};
struct EpiProj {
    static constexpr bool PERM = true, AFTER_DRAIN = false;
    bf16_t* O; int ldc; int split_cols; size_t split_stride; float scale0; const unsigned long long* ss; float inv_d, eps;
    __device__ __forceinline__ void operator()(const f32x4 (&acc)[2][2][4][2], const Unit& u, int wr, int wc, int fr, int fq) const {
        const int row0 = u.pm * BM + wr * 64 + fr; int colt = u.pn * BM; bf16_t* base = O;
        float sc = 1.f; { const int t = colt / split_cols; base += (size_t)t * split_stride; colt -= t * split_cols; if (t == 0) sc = scale0; }
        const int col0 = colt + wc * 32 + 8 * fq;
#pragma unroll
        for (int ai = 0; ai < 2; ++ai)
#pragma unroll
            for (int m = 0; m < 4; ++m) { const int row = row0 + ai * HALF + m * 16; bf16_t* rowp = base + (size_t)row * ldc + col0;
                const float r = ss ? sc * __builtin_amdgcn_rsqf((float)ss[row] * inv_d + eps) : sc;
#pragma unroll
                for (int bj = 0; bj < 2; ++bj) { const f32x4 v0 = acc[ai][bj][m][0] * r, v1 = acc[ai][bj][m][1] * r;
                    u32x4 w; w.x = cvt_pk_bf16(v0[0], v0[1]); w.y = cvt_pk_bf16(v0[2], v0[3]); w.z = cvt_pk_bf16(v1[0], v1[1]); w.w = cvt_pk_bf16(v1[2], v1[3]);
                    *(u32x4*)(rowp + bj * HALF) = w; } }
    }
};

template <bool BASE_BF16, bool OUT_F32, bool WRITE_XB> struct EpiRes2 {
    static constexpr bool PERM = false, AFTER_DRAIN = false;
    const void* base; float* out; bf16_t* xb; unsigned long long* ss; int ldc;
    __device__ __forceinline__ void operator()(const f32x4 (&acc)[2][2][4][2], const Unit& u, int wr, int wc, int fr, int fq) const {
        const int row0 = u.pm * BM + wr * 64 + fr, col0 = u.pn * BM + wc * 32 + 4 * fq;
#pragma unroll
        for (int ai = 0; ai < 2; ++ai)
#pragma unroll
            for (int m = 0; m < 4; ++m) { const int row = row0 + ai * HALF + m * 16; const size_t off = (size_t)row * ldc + col0; float s = 0.f;
#pragma unroll
                for (int bj = 0; bj < 2; ++bj)
#pragma unroll
                    for (int n = 0; n < 2; ++n) { const size_t o2 = off + bj * HALF + n * 16; f32x4 b;
                        if (BASE_BF16) { const unsigned long long w = *(const unsigned long long*)((const bf16_t*)base + o2);
                            b = (f32x4){__uint_as_float((unsigned)w << 16), __uint_as_float((unsigned)w & 0xffff0000u), __uint_as_float((unsigned)(w >> 32) << 16), __uint_as_float((unsigned)(w >> 32) & 0xffff0000u)}; }
                        else b = *(const f32x4*)((const float*)base + o2);
                        const f32x4 v = b + acc[ai][bj][m][n];
                        if (OUT_F32) *(f32x4*)(out + o2) = v;
                        s += (v[0] * v[0] + v[1] * v[1]) + (v[2] * v[2] + v[3] * v[3]);
                        if (WRITE_XB) *(unsigned long long*)(xb + o2) = (unsigned long long)cvt_pk_bf16(v[0], v[1]) | ((unsigned long long)cvt_pk_bf16(v[2], v[3]) << 32); }
                if (ss) { s += __shfl_xor(s, 16); s += __shfl_xor(s, 32); if (fq == 0) atomicAdd(ss + row, (unsigned long long)(s * 16777216.0f)); }
                asm volatile("" ::: "memory"); }
    }
};
template <class Epi, class Sched, bool ALIGN_EPI = false, bool SP2 = false>
__device__ __forceinline__ void gemm_phase(PG8_LAS unsigned char* lds, const Gemm g, const Sched& S, const Epi& E) {
    int tid_ = threadIdx.x; asm volatile("" : "+v"(tid_));
    const int tid = tid_, wid = __builtin_amdgcn_readfirstlane(tid >> 6), lane = tid & 63, wr = wid >> 2, wc = wid & 3, fr = lane & 15, fq = lane >> 4;
    const int K = g.K, nt = K / BK;
    unsigned voffA[2], voffB[2];
#pragma unroll
    for (int i = 0; i < 2; ++i) { int R, C; stage_rc(tid * 16 + i * 8192, R, C); const int Rb = Epi::PERM ? ((R & ~31) + perm32(R & 31)) : R;
        voffA[i] = (unsigned)(R * K + C) * 2u; voffB[i] = (unsigned)(Rb * K + C) * 2u; }
    const size_t kstep = (size_t)(BK * 2);
    const size_t hstep = (size_t)HALF * K * 2;
    const size_t tstep = 2 * hstep;
    const unsigned ldsw = (unsigned)wid * 1024u;
    const int aoff = lds_byte(wr * 64 + fr, fq * 8), boff = lds_byte(wc * 32 + fr, fq * 8);
#define PG8_SA(b, h) (((b) * 2 + (h)) * HTB)
#define PG8_SB(b, h) ((4 + (b) * 2 + (h)) * HTB)
#define PG8_STAGE(bufoff, gbase, voff) do { _Pragma("unroll") for (int _i = 0; _i < 2; ++_i) \
        __builtin_amdgcn_global_load_lds((const unsigned*)((const char*)(gbase) + (voff)[_i]), (PG8_LAS unsigned*)(lds + (bufoff) + ldsw + _i * 8192), 16, 0, 0); } while (0)
#define PG8_LDA(dst, b, h) do { _Pragma("unroll") for (int m = 0; m < 4; ++m) _Pragma("unroll") for (int k = 0; k < 2; ++k) dst[m][k] = *(const PG8_LAS bf16x8*)(lds + PG8_SA(b, h) + aoff + m * 2048 + k * 1024); } while (0)
#define PG8_LDB(dst, b, h) do { _Pragma("unroll") for (int n = 0; n < 2; ++n) _Pragma("unroll") for (int k = 0; k < 2; ++k) dst[n][k] = *(const PG8_LAS bf16x8*)(lds + PG8_SB(b, h) + boff + n * 2048 + k * 1024); } while (0)
#define PG8_MMA(ai, bj, At, Bt) do { __builtin_amdgcn_s_setprio(1); _Pragma("unroll") for (int m = 0; m < 4; ++m) _Pragma("unroll") for (int n = 0; n < 2; ++n) _Pragma("unroll") for (int k = 0; k < 2; ++k) \
        acc[ai][bj][m][n] = __builtin_amdgcn_mfma_f32_16x16x32_bf16(Bt[n][k], At[m][k], acc[ai][bj][m][n], 0, 0, 0); __builtin_amdgcn_s_setprio(0); } while (0)
#define PG8_WAIT_V(n) asm volatile("s_waitcnt vmcnt(" #n ")" ::: "memory")
#define PG8_WAIT_L(n) asm volatile("s_waitcnt lgkmcnt(" #n ")" ::: "memory")
#define PG8_BAR __builtin_amdgcn_s_barrier()
#define PG8_SCHED __builtin_amdgcn_sched_barrier(0)
    Unit cur, nxt; int ui = 0;
    if (!S.next(0, cur)) return;
    f32x4 acc[2][2][4][2];
#pragma unroll
    for (int a = 0; a < 2; ++a)
#pragma unroll
        for (int b = 0; b < 2; ++b)
#pragma unroll
            for (int m = 0; m < 4; ++m)
#pragma unroll
                for (int n = 0; n < 2; ++n) acc[a][b][m][n] = (f32x4){0.f, 0.f, 0.f, 0.f};
    bf16x8 At[4][2], B0[2][2], B1[2][2];
    const char* cA = (const char*)g.A + (size_t)cur.pm * tstep; const char* cB = (const char*)g.Bt + (size_t)cur.pn * tstep;
    S.a_ready(cur);
    if constexpr (SP2) {
        PG8_STAGE(PG8_SB(0, 0), cB, voffB); PG8_STAGE(PG8_SB(0, 1), cB + hstep, voffB); PG8_STAGE(PG8_SA(0, 0), cA, voffA); PG8_STAGE(PG8_SA(0, 1), cA + hstep, voffA);
        if (wr == 1) PG8_BAR;
        PG8_WAIT_V(2); PG8_BAR;
        PG8_STAGE(PG8_SB(1, 0), cB + kstep, voffB); PG8_STAGE(PG8_SA(1, 0), cA + kstep, voffA); PG8_STAGE(PG8_SB(1, 1), cB + hstep + kstep, voffB);
        PG8_WAIT_V(6); PG8_BAR;
    } else {
        PG8_STAGE(PG8_SB(0, 0), cB, voffB); PG8_STAGE(PG8_SA(0, 0), cA, voffA); PG8_STAGE(PG8_SB(0, 1), cB + hstep, voffB); PG8_STAGE(PG8_SA(0, 1), cA + hstep, voffA);
        if (wr == 1) PG8_BAR;
        PG8_WAIT_V(4); PG8_BAR;
        PG8_STAGE(PG8_SB(1, 0), cB + kstep, voffB); PG8_STAGE(PG8_SA(1, 0), cA + kstep, voffA); PG8_STAGE(PG8_SB(1, 1), cB + hstep + kstep, voffB);
        PG8_WAIT_V(6); PG8_BAR;
    }
    for (;;) {
        const bool has_next = S.next(ui + 1, nxt);
        const char* nA = has_next ? (const char*)g.A + (size_t)nxt.pm * tstep : cA; const char* nB = has_next ? (const char*)g.Bt + (size_t)nxt.pn * tstep : cB;
        for (int t = 0; t < nt; t += 2) {
            const bool last = (t == nt - 2);
            const char* a1 = cA + (size_t)(t + 1) * kstep;
            const char* a2 = last ? nA : cA + (size_t)(t + 2) * kstep; const char* b2 = last ? nB : cB + (size_t)(t + 2) * kstep;
            const char* a3 = a2 + kstep; const char* b3 = b2 + kstep;
            if (last && has_next) S.a_ready(nxt);
            if constexpr (SP2) {
            PG8_LDB(B0, 0, 0); PG8_LDB(B1, 0, 1); PG8_SCHED; PG8_LDA(At, 0, 0); PG8_STAGE(PG8_SA(1, 1), a1 + hstep, voffA);
            PG8_WAIT_V(8); PG8_WAIT_L(0); PG8_BAR; PG8_MMA(0, 0, At, B0); PG8_MMA(0, 1, At, B1); PG8_BAR; PG8_SCHED;
            PG8_LDA(At, 0, 1); PG8_STAGE(PG8_SB(0, 0), b2, voffB); PG8_STAGE(PG8_SB(0, 1), b2 + hstep, voffB); PG8_STAGE(PG8_SA(0, 0), a2, voffA);
            PG8_WAIT_V(8); PG8_WAIT_L(0); PG8_BAR; PG8_MMA(1, 0, At, B0); PG8_MMA(1, 1, At, B1); PG8_BAR; PG8_SCHED;
            PG8_LDB(B0, 1, 0); PG8_LDB(B1, 1, 1); PG8_SCHED; PG8_LDA(At, 1, 0); PG8_STAGE(PG8_SA(0, 1), a2 + hstep, voffA);
            PG8_WAIT_V(8); PG8_WAIT_L(0); PG8_BAR; PG8_MMA(0, 0, At, B0); PG8_MMA(0, 1, At, B1); PG8_BAR; PG8_SCHED;
            PG8_LDA(At, 1, 1); PG8_STAGE(PG8_SB(1, 0), b3, voffB); PG8_STAGE(PG8_SB(1, 1), b3 + hstep, voffB); PG8_STAGE(PG8_SA(1, 0), a3, voffA);
            PG8_WAIT_V(8); PG8_WAIT_L(0); PG8_BAR; PG8_MMA(1, 0, At, B0); PG8_MMA(1, 1, At, B1); PG8_BAR; PG8_SCHED;
            } else {
            PG8_LDB(B0, 0, 0); PG8_SCHED; PG8_LDA(At, 0, 0); PG8_STAGE(PG8_SA(1, 1), a1 + hstep, voffA);
            PG8_WAIT_L(8); PG8_BAR; PG8_WAIT_L(0); PG8_MMA(0, 0, At, B0); PG8_BAR; PG8_SCHED;
            PG8_LDB(B1, 0, 1); PG8_STAGE(PG8_SB(0, 0), b2, voffB);
            PG8_BAR; PG8_WAIT_L(0); PG8_MMA(0, 1, At, B1); PG8_BAR;
            PG8_LDA(At, 0, 1); PG8_STAGE(PG8_SA(0, 0), a2, voffA);
            PG8_BAR; PG8_WAIT_L(0); PG8_MMA(1, 0, At, B0); PG8_BAR; PG8_SCHED;
            PG8_STAGE(PG8_SB(0, 1), b2 + hstep, voffB);
            PG8_WAIT_V(6); PG8_BAR; PG8_MMA(1, 1, At, B1); PG8_BAR;
            PG8_LDB(B0, 1, 0); PG8_SCHED; PG8_LDA(At, 1, 0); PG8_STAGE(PG8_SA(0, 1), a2 + hstep, voffA);
            PG8_WAIT_L(8); PG8_BAR; PG8_WAIT_L(0); PG8_MMA(0, 0, At, B0); PG8_BAR; PG8_SCHED;
            PG8_LDB(B1, 1, 1); PG8_STAGE(PG8_SB(1, 0), b3, voffB);
            PG8_BAR; PG8_WAIT_L(0); PG8_MMA(0, 1, At, B1); PG8_BAR;
            PG8_LDA(At, 1, 1); PG8_STAGE(PG8_SA(1, 0), a3, voffA);
            PG8_BAR; PG8_WAIT_L(0); PG8_MMA(1, 0, At, B0); PG8_BAR; PG8_SCHED;
            PG8_STAGE(PG8_SB(1, 1), b3 + hstep, voffB);
            PG8_WAIT_V(6); PG8_BAR; PG8_MMA(1, 1, At, B1); PG8_BAR;
            }
        }
        if constexpr (ALIGN_EPI) { if (wr == 0) PG8_BAR; }
        if constexpr (!Epi::AFTER_DRAIN) { E(acc, cur, wr, wc, fr, fq); S.done(cur); }
        if (!has_next) break;
#pragma unroll
        for (int a = 0; a < 2; ++a)
#pragma unroll
            for (int b = 0; b < 2; ++b)
#pragma unroll
                for (int m = 0; m < 4; ++m)
#pragma unroll
                    for (int n = 0; n < 2; ++n) acc[a][b][m][n] = (f32x4){0.f, 0.f, 0.f, 0.f};
        cur = nxt; cA = nA; cB = nB; ++ui;
        if constexpr (ALIGN_EPI) { if (wr == 1) PG8_BAR; }
    }
    PG8_WAIT_V(0);
    if constexpr (!ALIGN_EPI) { if (wr == 0) PG8_BAR; }
    PG8_BAR;
    if constexpr (Epi::AFTER_DRAIN) { E.fused(acc, cur, wr, wc, fr, fq, lds, wid, lane); S.done(cur); }
#undef PG8_SA
#undef PG8_SB
#undef PG8_STAGE
#undef PG8_LDA
#undef PG8_LDB
#undef PG8_MMA
#undef PG8_WAIT_V
#undef PG8_WAIT_L
#undef PG8_BAR
#undef PG8_SCHED
}
}
namespace att {
#define ATT_LAS __attribute__((address_space(3)))
typedef unsigned short bf16_t;
typedef short bf16x8 __attribute__((ext_vector_type(8)));
typedef short s16x4 __attribute__((ext_vector_type(4)));
typedef short v4i16_t __attribute__((ext_vector_type(4)));
typedef float f32x16 __attribute__((ext_vector_type(16)));
typedef float f32x4 __attribute__((ext_vector_type(4)));
typedef unsigned u32x4 __attribute__((ext_vector_type(4)));
typedef float f32x2_t __attribute__((ext_vector_type(2)));
typedef __bf16 bf16x2_t __attribute__((ext_vector_type(2)));
constexpr int SEQ = 4096, PITCH = 2048, QB = 256, KVB = 64, TILE_BYTES = 16384;
constexpr int LDS_K = 0, LDS_V = 2 * TILE_BYTES, LDS_WS = 131072 + 2048, LDS_FLAG = LDS_WS + 8 * 256, LDS_BYTES = LDS_FLAG + 64;
constexpr float SB_DONE = -160.0f;
__device__ __forceinline__ unsigned off_b(unsigned row, unsigned ch) { return 256u * row + 16u * (ch ^ (((row & 3u) << 2) | ((row >> 2) & 3u))); }
__device__ __forceinline__ unsigned cvtpk(float lo, float hi) { f32x2_t v = {lo, hi}; bf16x2_t b = __builtin_convertvector(v, bf16x2_t); return __builtin_bit_cast(unsigned, b); }
__device__ __forceinline__ s16x4 vtr(const ATT_LAS unsigned char* p) { return __builtin_bit_cast(s16x4, __builtin_amdgcn_ds_read_tr16_b64_v4i16((ATT_LAS v4i16_t*)p)); }
#define ATT_MFMA(a, b, c) __builtin_amdgcn_mfma_f32_32x32x16_bf16((a), (b), (c), 0, 0, 0)

__device__ __forceinline__ const float* att_qgain();
__device__ __forceinline__ const float* att_rope();
template <int MODE, int NC, bool QROPE = false>
__device__ __forceinline__ void attn_unit(ATT_LAS unsigned char* lds, const bf16_t* __restrict__ Qp, const bf16_t* __restrict__ Kp, const bf16_t* __restrict__ Vp, void* Op, int q0) {
  int tid_ = threadIdx.x; asm volatile("" : "+v"(tid_));
  const int tid = tid_, lane = tid & 63, r32 = lane & 31, hi = lane >> 5;
  const int wid = __builtin_amdgcn_readfirstlane(tid >> 6);
  const int qrow0 = q0 + 32 * wid, t = qrow0 + r32;
  const int NT = (q0 + QB) / KVB;
  bf16x8 qf[8];
#pragma unroll
  for (int s = 0; s < 8; ++s) qf[s] = *(const bf16x8*)(Qp + (size_t)t * PITCH + 16 * s + 8 * hi);
  if (QROPE) {
    const float* __restrict__ qgain = att_qgain(); const float* __restrict__ rope = att_rope(); constexpr float qscale = 0.08838834764831845f * 1.4426950408889634f;
    float ss = 0.f;
#pragma unroll
    for (int s = 0; s < 8; ++s)
#pragma unroll
      for (int e = 0; e < 8; ++e) { const float v = __uint_as_float(((unsigned)(unsigned short)qf[s][e]) << 16); ss += v * v; }
    ss += __shfl_xor(ss, 32);
    const float rr = 1.0f / sqrtf(ss * (1.0f / 128.0f) + 1e-6f);
    const float* cs = rope + (size_t)t * 128;
#pragma unroll
    for (int s = 0; s < 4; ++s) {
      u32x4 wa, wb;
#pragma unroll
      for (int e = 0; e < 8; e += 2) {
        float oa[2], ob[2];
#pragma unroll
        for (int h2 = 0; h2 < 2; ++h2) { const int i = 16 * s + 8 * hi + e + h2;
          const float xa = __uint_as_float(((unsigned)(unsigned short)qf[s][e + h2]) << 16), xb = __uint_as_float(((unsigned)(unsigned short)qf[s + 4][e + h2]) << 16);
          const float ya = xa * rr * qgain[i], yb = xb * rr * qgain[64 + i], co = cs[2 * i], si = cs[2 * i + 1];
          oa[h2] = (ya * co - yb * si) * qscale; ob[h2] = (yb * co + ya * si) * qscale; }
        wa[e >> 1] = cvtpk(oa[0], oa[1]); wb[e >> 1] = cvtpk(ob[0], ob[1]);
      }
      qf[s] = __builtin_bit_cast(bf16x8, wa); qf[s + 4] = __builtin_bit_cast(bf16x8, wb);
    }
  }
  constexpr int VBUF = (NC / 4) * TILE_BYTES;
#define ATT_DMA(jt_, kbuf_, vbuf_) do { const size_t go_ = (size_t)(KVB * (jt_)) * PITCH; unsigned l_ = (unsigned)lane; asm volatile("" : "+v"(l_)); unsigned kgl[2]; \
    _Pragma("unroll") for (int i2 = 0; i2 < 2; ++i2) { const unsigned pc = 2u * wid + i2, rr = 4u * pc + (l_ >> 4), ch = (l_ & 15u) ^ (((l_ >> 4) & 3u) << 2 | (pc & 3u)); kgl[i2] = rr * PITCH + 8u * ch; } \
    _Pragma("unroll") for (int i2 = 0; i2 < 2; ++i2) { \
      __builtin_amdgcn_global_load_lds((const unsigned*)(Kp + go_ + kgl[i2]), (ATT_LAS unsigned*)(lds + LDS_K + (kbuf_) * TILE_BYTES + wid * 2048 + i2 * 1024), 16, 0, 0); \
      _Pragma("unroll") for (int hf = 0; hf < NC / 4; ++hf) \
        __builtin_amdgcn_global_load_lds((const unsigned*)(Vp + go_ + 128 * hf + kgl[i2]), (ATT_LAS unsigned*)(lds + LDS_V + (vbuf_) * VBUF + hf * TILE_BYTES + wid * 2048 + i2 * 1024), 16, 0, 0); } } while (0)
  const unsigned kbase = 256u * (unsigned)r32, kx = 16u * ((unsigned)hi ^ ((((unsigned)r32 & 3u) << 2) | (((unsigned)r32 >> 2) & 3u)));
  const unsigned vq = ((unsigned)lane & 15u) >> 2;
  unsigned vbase[2];
  { const unsigned p = (unsigned)lane & 3u, blk = ((unsigned)lane >> 4) & 1u, low = 2u * blk + (p >> 1);
#pragma unroll
    for (int jj = 0; jj < 2; ++jj) vbase[jj] = 256u * (8u * jj + 4u * hi + vq) + 16u * (low ^ (2u * jj + hi)) + 8u * (p & 1u); }
  ATT_LAS float* wsf = (ATT_LAS float*)(lds + LDS_WS) + wid * 64;
  ATT_LAS unsigned* flags = (ATT_LAS unsigned*)(lds + LDS_FLAG);
  f32x16 o[NC];
#pragma unroll
  for (int c = 0; c < NC; ++c)
#pragma unroll
    for (int r = 0; r < 16; ++r) o[c][r] = 0.f;
  float m_run = -INFINITY, l_run = 0.f, carry = 0.f;
  bool wdone = false;
  const bool lag = wid >= 4;
  bool pend = false; unsigned pvb = 0u;
  u32x4 pk[4];
#pragma unroll
  for (int s4 = 0; s4 < 4; ++s4) pk[s4] = (u32x4){0u, 0u, 0u, 0u};
#define ATT_PV(VB_) do { const ATT_LAS unsigned char* vb = (VB_); __builtin_amdgcn_s_setprio(1); \
    _Pragma("unroll") for (int s4 = 0; s4 < 4; ++s4) { const bf16x8 pa = __builtin_bit_cast(bf16x8, pk[s4]); \
      _Pragma("unroll") for (int c = 0; c < NC; ++c) { const unsigned vo = 64u * ((unsigned)(c & 3) ^ vq) + (c >> 2) * TILE_BYTES + 4096 * s4; \
        const s16x4 lo = vtr(vb + vbase[0] + vo), hh = vtr(vb + vbase[1] + vo); \
        const bf16x8 vf = __builtin_shufflevector(lo, hh, 0, 1, 2, 3, 4, 5, 6, 7); \
        o[c] = ATT_MFMA(pa, vf, o[c]); } \
      if (NC == 8) __builtin_amdgcn_sched_barrier(0); } \
    __builtin_amdgcn_s_setprio(0); } while (0)
  ATT_DMA(MODE == 0 ? NT - 1 : 0, 0, 0);
  asm volatile("s_waitcnt vmcnt(0)" ::: "memory");
  __syncthreads();
  int vcur = 0;
  for (int i = 0; i < NT; ++i) {
    const int jt = MODE == 0 ? NT - 1 - i : i; const int buf = i & 1; const int kv0 = KVB * jt;
    const bool more = i + 1 < NT;
    const int vnext = vcur == 2 ? 0 : vcur + 1;
    if (more) ATT_DMA(MODE == 0 ? jt - 1 : jt + 1, buf ^ 1, vnext);
    if (lag && pend) { ATT_PV(lds + LDS_V + pvb); pend = false; }
    const bool active = MODE == 0 ? (kv0 < qrow0 + 31 && !wdone) : (kv0 <= qrow0 + 31);
    f32x16 p0, p1;
    if (active) {
      const ATT_LAS unsigned char* kb = lds + LDS_K + buf * TILE_BYTES;
#pragma unroll
      for (int r = 0; r < 16; ++r) { p0[r] = 0.f; p1[r] = 0.f; }
      __builtin_amdgcn_s_setprio(1);
#pragma unroll
      for (int s = 0; s < 8; ++s) {
        const unsigned ko = kbase + ((32u * s) ^ kx);
        const bf16x8 k0 = *(const ATT_LAS bf16x8*)(kb + ko);
        const bf16x8 k1 = *(const ATT_LAS bf16x8*)(kb + ko + 8192);
        p0 = ATT_MFMA(k0, qf[s], p0); p1 = ATT_MFMA(k1, qf[s], p1);
      }
      __builtin_amdgcn_s_setprio(0);
      if (MODE == 1) {
        const bool full = (kv0 + 63 <= qrow0);
        if (!full) {
#pragma unroll
          for (int r = 0; r < 16; ++r) { const int kv = kv0 + (r & 3) + 8 * (r >> 2) + 4 * hi; if (kv > t) p0[r] = -INFINITY; if (kv + 32 > t) p1[r] = -INFINITY; }
        }
        float mx = __builtin_fmaxf(__builtin_fmaxf(p0[0], p1[0]), __builtin_fmaxf(p0[1], p1[1]));
#pragma unroll
        for (int r = 2; r < 16; r += 2) mx = __builtin_fmaxf(__builtin_fmaxf(mx, __builtin_fmaxf(p0[r], p1[r])), __builtin_fmaxf(p0[r + 1], p1[r + 1]));
        mx = fmaxf(mx, __shfl_xor(mx, 32));
        float alpha = 1.0f;
        const bool upd = __builtin_amdgcn_ballot_w64(mx > m_run + 8.0f) != 0ull;
        if (upd) { const float m_new = fmaxf(m_run, mx); alpha = __builtin_amdgcn_exp2f(m_run - m_new); m_run = m_new; }
        float rs = 0.f;
#pragma unroll
        for (int r = 0; r < 16; ++r) { p0[r] = __builtin_amdgcn_exp2f(p0[r] - m_run); p1[r] = __builtin_amdgcn_exp2f(p1[r] - m_run); rs += p0[r] + p1[r]; }
        l_run = l_run * alpha + rs;
        if (upd) {
          if (hi == 0) wsf[r32] = alpha;
#pragma unroll
          for (int g = 0; g < 4; ++g) { const f32x4 a4 = *(const ATT_LAS f32x4*)(wsf + 8 * g + 4 * hi);
#pragma unroll
            for (int c = 0; c < NC; ++c)
#pragma unroll
              for (int e = 0; e < 4; ++e) o[c][4 * g + e] *= a4[e]; }
        }
      } else {
        const bool full = (kv0 + 63 < qrow0);
        float l1a[16], l1b[16];
#pragma unroll
        for (int r = 0; r < 16; ++r) {
          const int kv = kv0 + (r & 3) + 8 * (r >> 2) + 4 * hi;
          { const float z = p0[r]; const float e = __builtin_amdgcn_exp2f(-fabsf(z)); const float lg = __builtin_amdgcn_logf(1.0f + e);
            float v = -(fmaxf(z, 0.f) + lg); if (!full && !(kv < t)) v = 0.f; l1a[r] = v; }
          { const float z = p1[r]; const float e = __builtin_amdgcn_exp2f(-fabsf(z)); const float lg = __builtin_amdgcn_logf(1.0f + e);
            float v = -(fmaxf(z, 0.f) + lg); if (!full && !(kv + 32 < t)) v = 0.f; l1b[r] = v; }
        }
        float SM[9], SP[9]; SM[8] = 0.f; SP[8] = 0.f;
#pragma unroll
        for (int g = 3; g >= 0; --g) SM[4 + g] = ((l1b[4 * g] + l1b[4 * g + 1]) + (l1b[4 * g + 2] + l1b[4 * g + 3])) + SM[5 + g];
#pragma unroll
        for (int g = 3; g >= 0; --g) SM[g] = ((l1a[4 * g] + l1a[4 * g + 1]) + (l1a[4 * g + 2] + l1a[4 * g + 3])) + SM[1 + g];
#pragma unroll
        for (int i2 = 0; i2 < 8; ++i2) SP[i2] = __shfl_xor(SM[i2], 32);
#pragma unroll
        for (int i2 = 0; i2 < 8; ++i2) {
          float later = carry + SM[i2 + 1] + (hi ? SP[i2 + 1] : SP[i2]);
#pragma unroll
          for (int e = 3; e >= 0; --e) {
            const int r = 4 * (i2 & 3) + e; const int kv = kv0 + 32 * (i2 >> 2) + e + 8 * (i2 & 3) + 4 * hi;
            const float z = (i2 >> 2) ? p1[r] : p0[r]; const float l1 = (i2 >> 2) ? l1b[r] : l1a[r];
            float a = __builtin_amdgcn_exp2f(z + l1 + later); if (!full && !(kv < t)) a = 0.f;
            if (i2 >> 2) p1[r] = a; else p0[r] = a;
            later += l1;
          }
        }
        carry += SM[0] + SP[0];
        wdone = (__builtin_amdgcn_ballot_w64(carry >= SB_DONE) == 0ull);
      }
    }
    if (active) {
      pk[0] = (u32x4){cvtpk(p0[0], p0[1]), cvtpk(p0[2], p0[3]), cvtpk(p0[4], p0[5]), cvtpk(p0[6], p0[7])};
      pk[1] = (u32x4){cvtpk(p0[8], p0[9]), cvtpk(p0[10], p0[11]), cvtpk(p0[12], p0[13]), cvtpk(p0[14], p0[15])};
      pk[2] = (u32x4){cvtpk(p1[0], p1[1]), cvtpk(p1[2], p1[3]), cvtpk(p1[4], p1[5]), cvtpk(p1[6], p1[7])};
      pk[3] = (u32x4){cvtpk(p1[8], p1[9]), cvtpk(p1[10], p1[11]), cvtpk(p1[12], p1[13]), cvtpk(p1[14], p1[15])};
      if (lag) { pend = true; pvb = (unsigned)(vcur * VBUF); }
      else ATT_PV(lds + LDS_V + vcur * VBUF);
    }
    vcur = vnext;
    if (MODE == 0) { if (lane == 0) flags[(i & 1) * 8 + wid] = wdone ? 1u : 0u; }
    asm volatile("s_waitcnt vmcnt(0)" ::: "memory");
    __syncthreads();
    if (MODE == 0) {
      const u32x4 fa = *(const ATT_LAS u32x4*)(flags + (i & 1) * 8), fb = *(const ATT_LAS u32x4*)(flags + (i & 1) * 8 + 4);
      const unsigned all = fa[0] & fa[1] & fa[2] & fa[3] & fb[0] & fb[1] & fb[2] & fb[3];
      if (__builtin_amdgcn_readfirstlane(all) != 0u) break;
    }
  }
  if (lag && pend) ATT_PV(lds + LDS_V + pvb);
  if (MODE == 1) {
    const float l = l_run + __shfl_xor(l_run, 32);
    if (hi == 0) wsf[r32] = 1.0f / l;
    bf16_t* O = (bf16_t*)Op;
#pragma unroll
    for (int g = 0; g < 4; ++g) { const f32x4 i4 = *(const ATT_LAS f32x4*)(wsf + 8 * g + 4 * hi);
#pragma unroll
      for (int e = 0; e < 4; ++e) { bf16_t* orow = O + (size_t)(qrow0 + 8 * g + 4 * hi + e) * PITCH + r32;
#pragma unroll
        for (int c = 0; c < NC; ++c) orow[32 * c] = (bf16_t)(cvtpk(o[c][4 * g + e] * i4[e], 0.f) & 0xffffu); } }
  } else {
    bf16_t* O = (bf16_t*)Op;
#pragma unroll
    for (int g = 0; g < 4; ++g)
#pragma unroll
      for (int e = 0; e < 4; ++e) { bf16_t* orow = O + (size_t)(qrow0 + 8 * g + 4 * hi + e) * PITCH + r32;
#pragma unroll
        for (int c = 0; c < NC; ++c) orow[32 * c] = (bf16_t)(cvtpk(o[c][4 * g + e], 0.f) & 0xffffu); }
  }
  __syncthreads();
}
#undef ATT_MFMA
#undef ATT_DMA
#undef ATT_PV
}
#define GAS __attribute__((address_space(1)))
#define LAS __attribute__((address_space(3)))
typedef unsigned short bf16;
typedef unsigned v4u __attribute__((ext_vector_type(4)));
typedef float f32x4 __attribute__((ext_vector_type(4)));
typedef short bf16x8 __attribute__((ext_vector_type(8)));
typedef GAS unsigned gu32;
typedef GAS unsigned long long gu64;
#define RLX_AGENT __ATOMIC_RELAXED, __HIP_MEMORY_SCOPE_AGENT
#define LDS_WAIT() asm volatile("s_waitcnt lgkmcnt(0)" ::: "memory")
#define VM_WAIT() asm volatile("s_waitcnt vmcnt(0)" ::: "memory")
__device__ __forceinline__ unsigned long long rt() { return __builtin_amdgcn_s_memrealtime(); }
__device__ __forceinline__ unsigned f2bf(float f) { unsigned u = __builtin_bit_cast(unsigned, f); return (u + 0x7fffu + ((u >> 16) & 1u)) >> 16; }
__device__ __forceinline__ unsigned pk2(float lo, float hi) { return f2bf(lo) | (f2bf(hi) << 16); }

#define XB_TMO      128
#define XB_XCNT(j)  (256  + 64 * (j))
#define XB_XSUB(j)  (1280 + 64 * (j))
#define XB_XGEN(j)  (2304 + 64 * (j))
#define XB_TOP      3328
#define XB_TOPGEN   3392
#define XCD_BAR_WORDS 3456
#define XB_SPIN_CAP (1u << 18)

__device__ __forceinline__ unsigned xb_ld(unsigned* p)              { return __hip_atomic_load(p, __ATOMIC_RELAXED, __HIP_MEMORY_SCOPE_AGENT); }
__device__ __forceinline__ unsigned xb_add(unsigned* p, unsigned v) { return __hip_atomic_fetch_add(p, v, __ATOMIC_RELAXED, __HIP_MEMORY_SCOPE_AGENT); }
__device__ __forceinline__ unsigned xb_xcc_id() { return (unsigned)__builtin_amdgcn_s_getreg((3 << 11) | 20) & 0xFu; }
#define XB_SPIN(cond, bar) do { unsigned _sp = 0; while (cond) { __builtin_amdgcn_s_sleep(1); \
    if ((++_sp & 255u) == 0u) { if (xb_ld(&(bar)[XB_TMO])) break; if (_sp > XB_SPIN_CAP) { atomicAdd(&(bar)[XB_TMO], 1u); break; } } } } while (0)

struct XcdBarrier {
    unsigned* bar; unsigned x;
    volatile LAS unsigned* st;
};

__device__ __forceinline__ XcdBarrier xcd_barrier_post(unsigned* bar, volatile LAS unsigned* st) {
    XcdBarrier b; b.bar = bar; b.x = xb_xcc_id(); b.st = st;
    if (threadIdx.x == 0) (void)xb_add(&bar[XB_XCNT(b.x)], 1u);
    return b;
}
__device__ __forceinline__ void xcd_barrier_complete(unsigned* bar, unsigned x, unsigned& nloc, unsigned& nx) {
    const unsigned G = gridDim.x * gridDim.y * gridDim.z;
    unsigned sum, cnt, mine, sp = 0u;
    for (;;) {
        sum = 0u; cnt = 0u; mine = 0u;
#pragma unroll
        for (unsigned j = 0; j < 16; ++j) { const unsigned c = xb_ld(&bar[XB_XCNT(j)]); sum += c; cnt += (c > 0u) ? 1u : 0u; mine = (j == x) ? c : mine; }
        if (sum == G) break;
        __builtin_amdgcn_s_sleep(1);
        if ((++sp & 255u) == 0u) { if (xb_ld(&bar[XB_TMO])) break; if (sp > XB_SPIN_CAP) { atomicAdd(&bar[XB_TMO], 1u); break; } }
    }
    nloc = mine > 0u ? mine : 1u; nx = cnt > 0u ? cnt : 1u;
}

__device__ __forceinline__ void xcd_barrier(const XcdBarrier& b) {
    asm volatile("s_waitcnt vmcnt(0)" ::: "memory");
    __syncthreads();
    if (threadIdx.x == 0) {
        unsigned* bar = b.bar;
        __builtin_amdgcn_s_waitcnt(0);
        unsigned nloc = b.st[0], nx = b.st[1];
        if (nloc == 0u) { xcd_barrier_complete(bar, b.x, nloc, nx); b.st[0] = nloc; b.st[1] = nx; }
        const unsigned old = xb_add(&bar[XB_XSUB(b.x)], 1u);
        const unsigned gen = old / nloc;
        if (old + 1u == (gen + 1u) * nloc) {
            __builtin_amdgcn_fence(__ATOMIC_RELEASE, "agent");
            asm volatile("s_waitcnt vmcnt(0)" ::: "memory");
            const unsigned og = xb_add(&bar[XB_TOP], 1u);
            const unsigned tg = og / nx;
            if (og + 1u == (tg + 1u) * nx) xb_add(&bar[XB_TOPGEN], 1u);
            else XB_SPIN(xb_ld(&bar[XB_TOPGEN]) == tg, bar);
            __builtin_amdgcn_fence(__ATOMIC_ACQUIRE, "agent");
            xb_add(&bar[XB_XGEN(b.x)], 1u);
            asm volatile("s_waitcnt vmcnt(0)" ::: "memory");
        } else {
            XB_SPIN(xb_ld(&bar[XB_XGEN(b.x)]) == gen, bar);
            __builtin_amdgcn_fence(__ATOMIC_ACQUIRE, "agent");
            asm volatile("s_waitcnt vmcnt(0)" ::: "memory");
        }
    }
    __syncthreads();
}
constexpr int NWAVES = 8;
constexpr int BATCH = 2, SEQ = 4096, D = 2048, M = BATCH * SEQ, FF = 5632, NPROJ = 6144;
constexpr float EPS = 1e-6f;
constexpr float C2 = 0.08838834764831845f * 1.4426950408889634f;
constexpr float LAMBDA_INIT = 0.35550906759f;
constexpr size_t MiB = 1u << 20;
constexpr size_t WS_CTL = 0, CTL_ZERO_BYTES = 65536 + 3 * 65536;
constexpr size_t WS_SS = 65536;
constexpr size_t WS_ROPE = 1 * MiB;
constexpr size_t WS_WKVQ = 4 * MiB, WS_WO_B = 28 * MiB, WS_WGU_B = 36 * MiB, WS_WD_B = 80 * MiB;
constexpr size_t WS_AB = 102 * MiB;
constexpr size_t WS_P0 = 134 * MiB, WS_P1 = 166 * MiB, WS_P2 = 198 * MiB;
constexpr size_t WS_ACT = 230 * MiB;
constexpr size_t WS_WQKV_A = 318 * MiB, WS_WO_A = 342 * MiB, WS_WGU_A = 350 * MiB, WS_WD_A = 394 * MiB;
constexpr size_t WS_OB = 318 * MiB;
constexpr size_t WS_XB = 416 * MiB;
constexpr size_t WS_END = 448 * MiB;
constexpr int CW_BAR = 1024;
constexpr int RING_BYTES = 131072, LDSCTL_OFF = RING_BYTES, MISC_OFF = LDSCTL_OFF + 320, LDS_BYTES = 147456;
static_assert(att::LDS_BYTES <= LDS_BYTES && att::LDS_WS >= MISC_OFF + 128 && (2 + 3 * 2) * att::TILE_BYTES <= RING_BYTES && (3 + 4) * att::TILE_BYTES <= RING_BYTES, "attention LDS");

__device__ __forceinline__ float wave_sum(float v) {
#pragma unroll
    for (int o = 1; o < 64; o <<= 1) v += __shfl_xor(v, o);
    return v;
}
__device__ __forceinline__ void transpose_item(const float* __restrict__ W, int K, int N, bf16* WT, int row_off, int gu_map, const float* __restrict__ gain, LAS float* scr, int item, int lane) {
    const int nblk = N / 32, kb = item / nblk, nb = item - kb * nblk, k0 = 64 * kb, n0 = 32 * nb;
    float wv[32];
#pragma unroll
    for (int i = 0; i < 32; ++i) { const int kk = 2 * i + (lane >> 5); wv[i] = __builtin_nontemporal_load(W + (size_t)(k0 + kk) * N + n0 + (lane & 31)); }
    if (gain) {
#pragma unroll
        for (int i = 0; i < 32; ++i) wv[i] *= gain[k0 + 2 * i + (lane >> 5)];
    }
#pragma unroll
    for (int i = 0; i < 32; ++i) scr[(2 * i + (lane >> 5)) * 33 + (lane & 31)] = wv[i];
    LDS_WAIT(); asm volatile("" ::: "memory");
    int drow0 = row_off + n0;
    if (gu_map) { const int half = N / 2, isup = n0 >= half ? 1 : 0, j = n0 - isup * half; drow0 = 256 * (j >> 7) + 128 * isup + (j & 127); }
    const int c = lane & 7;
#pragma unroll
    for (int j = 0; j < 4; ++j) { const int n = (lane >> 3) + 8 * j; const LAS float* s = scr + (8 * c) * 33 + n;
        v4u o; o.x = pk2(s[0 * 33], s[1 * 33]); o.y = pk2(s[2 * 33], s[3 * 33]); o.z = pk2(s[4 * 33], s[5 * 33]); o.w = pk2(s[6 * 33], s[7 * 33]);
        *(GAS v4u*)(WT + (size_t)(drow0 + n) * K + k0 + 8 * c) = o; }
    LDS_WAIT(); asm volatile("" ::: "memory");
}
__device__ __forceinline__ void xb_rows(const float* X, bf16* out, unsigned long long* ss, int gw, int NGW, int lane) {
    for (int m = gw; m < M; m += NGW) {
        const GAS f32x4* xr = (const GAS f32x4*)(X + (size_t)m * D) + lane;
        f32x4 v[8]; float s = 0.f;
#pragma unroll
        for (int j = 0; j < 8; ++j) { v[j] = xr[64 * j]; s += (v[j].x * v[j].x + v[j].y * v[j].y) + (v[j].z * v[j].z + v[j].w * v[j].w); }
        s = wave_sum(s);
        if (lane == 0) ss[m] = (unsigned long long)(s * 16777216.0f);
        GAS unsigned long long* o8 = (GAS unsigned long long*)(out + (size_t)m * D) + lane;
#pragma unroll
        for (int j = 0; j < 8; ++j) o8[64 * j] = (unsigned long long)pk2(v[j].x, v[j].y) | ((unsigned long long)pk2(v[j].z, v[j].w) << 32);
    }
}
__device__ __forceinline__ void rms_rows(const float* X, bf16* out, int gw, int NGW, int lane) {
    for (int m = gw; m < M; m += NGW) {
        const GAS f32x4* xr = (const GAS f32x4*)(X + (size_t)m * D) + lane;
        f32x4 v[8]; float s = 0.f;
#pragma unroll
        for (int j = 0; j < 8; ++j) { v[j] = xr[64 * j]; s += (v[j].x * v[j].x + v[j].y * v[j].y) + (v[j].z * v[j].z + v[j].w * v[j].w); }
        const float r = 1.0f / sqrtf(wave_sum(s) * (1.0f / D) + EPS);
        GAS unsigned long long* o8 = (GAS unsigned long long*)(out + (size_t)m * D) + lane;
#pragma unroll
        for (int j = 0; j < 8; ++j) o8[64 * j] = (unsigned long long)pk2(v[j].x * r, v[j].y * r) | ((unsigned long long)pk2(v[j].z * r, v[j].w * r) << 32);
    }
}
__device__ __forceinline__ float bf2f(unsigned short h) { return __uint_as_float(((unsigned)h) << 16); }
__device__ __forceinline__ void qknorm_rope_row(bf16* row, const float* __restrict__ gain, float sc, const float* __restrict__ cs  , int lane) {
    const int cc = lane & 7;
    float ga[8], gb[8], co[8], si[8];
#pragma unroll
    for (int e = 0; e < 8; ++e) { ga[e] = gain[8 * cc + e]; gb[e] = gain[64 + 8 * cc + e]; co[e] = cs[2 * (8 * cc + e)]; si[e] = cs[2 * (8 * cc + e) + 1]; }
#pragma unroll
    for (int it = 0; it < 2; ++it) {
        bf16* p = row + 128 * (8 * it + (lane >> 3)) + 8 * cc;
        const v4u a = *(const GAS v4u*)p, b = *(const GAS v4u*)(p + 64);
        float xa[8], xb[8]; float ss = 0.f;
#pragma unroll
        for (int e = 0; e < 4; ++e) { xa[2 * e] = __uint_as_float(a[e] << 16); xa[2 * e + 1] = __uint_as_float(a[e] & 0xffff0000u); xb[2 * e] = __uint_as_float(b[e] << 16); xb[2 * e + 1] = __uint_as_float(b[e] & 0xffff0000u); }
#pragma unroll
        for (int e = 0; e < 8; ++e) ss += xa[e] * xa[e] + xb[e] * xb[e];
        ss += __shfl_xor(ss, 1); ss += __shfl_xor(ss, 2); ss += __shfl_xor(ss, 4);
        const float r = 1.0f / sqrtf(ss * (1.0f / 128.0f) + EPS);
        float oa[8], ob[8];
#pragma unroll
        for (int e = 0; e < 8; ++e) { const float ya = xa[e] * r * ga[e], yb = xb[e] * r * gb[e]; oa[e] = (ya * co[e] - yb * si[e]) * sc; ob[e] = (yb * co[e] + ya * si[e]) * sc; }
        v4u wa, wb;
#pragma unroll
        for (int e = 0; e < 4; ++e) { wa[e] = pk2(oa[2 * e], oa[2 * e + 1]); wb[e] = pk2(ob[2 * e], ob[2 * e + 1]); }
        *(GAS v4u*)p = wa; *(GAS v4u*)(p + 64) = wb;
    }
}

struct Args { const float* in[22]; float* out; unsigned char* ws; };
typedef __attribute__((address_space(4))) const Args* ArgsCP;
__device__ __forceinline__ ArgsCP argp() { ArgsCP p = (ArgsCP)__builtin_amdgcn_kernarg_segment_ptr(); asm volatile("" : "+s"(p)); return p; }


#ifndef MK_CG_ALL
#define MK_CG_ALL 0
#endif
#if MK_CG_ALL
#define GSYNC() cg::this_grid().sync()
#else
#define GSYNC() do { XcdBarrier b_; b_.bar = (unsigned*)((gu32*)(argp()->ws + WS_CTL) + CW_BAR); b_.x = xb_xcc_id(); b_.st = (volatile LAS unsigned*)(lds + MISC_OFF) + 8; xcd_barrier(b_); } while (0)
#endif
__device__ __forceinline__ int opaque_tid() { int t = threadIdx.x; asm volatile("" : "+v"(t)); return t; }
namespace att {
__device__ __forceinline__ const float* att_qgain() { return argp()->in[12]; }
__device__ __forceinline__ const float* att_rope() { return (const float*)(argp()->ws + WS_ROPE); }
}
template <int L>
__device__ __forceinline__ void layer_body(LAS unsigned char* lds, unsigned char* ws, const float* x, float* out,
                                           int G, int bx, int vcu, int gw, int NGW) {
    bf16* AB = (bf16*)(ws + WS_AB); bf16* P0 = (bf16*)(ws + WS_P0); bf16* P1 = (bf16*)(ws + WS_P1); bf16* P2 = (bf16*)(ws + WS_P2);
    bf16* ACT = (bf16*)(ws + WS_ACT); bf16* OB = (bf16*)(ws + WS_OB); float* ROPE = (float*)(ws + WS_ROPE);
        bf16* XB = (bf16*)(ws + WS_XB); unsigned long long* SS = (unsigned long long*)(ws + WS_SS);
        {
            pg8::Gemm g{XB, (const bf16*)(ws + (L == 0 ? WS_WQKV_A : WS_WKVQ)), M, NPROJ, D}; pg8::StaticOrder S; S.init(M, NPROJ, G, bx);
            pg8::EpiProj E{P0, D, D, (size_t)(WS_P1 - WS_P0) / 2, L == 0 ? C2 : 1.0f, L == 0 ? SS + 3 * (size_t)M : SS + M, (1.0f / D) * (1.0f / 16777216.0f), EPS};
            pg8::gemm_phase<pg8::EpiProj, pg8::StaticOrder, true, true>(lds, g, S, E);
        }
        GSYNC();
        if constexpr (L == 0) {
            constexpr int TOTAL = 32 * 16; const int per = (TOTAL + G - 1) / G;
            for (int idx = vcu * per; idx < (vcu + 1) * per && idx < TOTAL; ++idx) {
                const int hp = idx >> 4, k = idx & 15, qb = (k & 1) ? 15 - (k >> 1) : (k >> 1);
                const size_t base = (size_t)(hp >> 4) * SEQ * D + 128 * (hp & 15);
                att::attn_unit<0, 4>(lds, P0 + base, P1 + base, P2 + base, (void*)(AB + base), qb * att::QB);
            }
            GSYNC();
        } else {
            const int lane = opaque_tid() & 63;
            for (int m = gw; m < M; m += NGW) qknorm_rope_row(P0 + (size_t)m * D, argp()->in[9], 1.0f, ROPE + (size_t)(m & (SEQ - 1)) * 128, lane);
            GSYNC();
            constexpr int TOTAL = 32 * 16; const int per = (TOTAL + G - 1) / G;
            for (int idx = vcu * per; idx < (vcu + 1) * per && idx < TOTAL; ++idx) {
                const int hp = idx >> 4, k = idx & 15, qb = (k & 1) ? 15 - (k >> 1) : (k >> 1);
                const int c = hp & 1, h = (hp >> 1) & 7, b = hp >> 4;
                const size_t rb = (size_t)b * SEQ * D;
                att::attn_unit<1, 8, true>(lds, P2 + rb + (2 * h + c) * 128, P0 + rb + (2 * h + c) * 128, P1 + rb + 256 * h, (void*)(OB + (size_t)c * M * D + rb + 256 * h), qb * att::QB);
            }
            GSYNC();
            {
                const int lane = opaque_tid() & 63;
                const float a1 = argp()->in[13][lane] * argp()->in[14][lane] + argp()->in[13][lane + 64] * argp()->in[14][lane + 64];
                const float a2 = argp()->in[15][lane] * argp()->in[16][lane] + argp()->in[15][lane + 64] * argp()->in[16][lane + 64];
                const float lam = expf(wave_sum(a1)) - expf(wave_sum(a2)) + LAMBDA_INIT;
                const f32x4 gs = *(const GAS f32x4*)(argp()->in[17] + 4 * lane);
                for (int m = gw; m < M; m += NGW) {
#pragma unroll
                    for (int h = 0; h < 8; ++h) {
                        const size_t off = (size_t)m * D + 256 * h + 4 * lane;
                        const unsigned long long w0 = *(const GAS unsigned long long*)(OB + off), w1 = *(const GAS unsigned long long*)(OB + (size_t)M * D + off);
                        const f32x4 o0 = {__uint_as_float((unsigned)w0 << 16), __uint_as_float((unsigned)w0 & 0xffff0000u), __uint_as_float((unsigned)(w0 >> 32) << 16), __uint_as_float((unsigned)(w0 >> 32) & 0xffff0000u)};
                        const f32x4 o1 = {__uint_as_float((unsigned)w1 << 16), __uint_as_float((unsigned)w1 & 0xffff0000u), __uint_as_float((unsigned)(w1 >> 32) << 16), __uint_as_float((unsigned)(w1 >> 32) & 0xffff0000u)};
                        const f32x4 o = o0 - lam * o1;
                        const float ss = wave_sum((o.x * o.x + o.y * o.y) + (o.z * o.z + o.w * o.w));
                        const float r = (1.0f - LAMBDA_INIT) / sqrtf(ss * (1.0f / 256.0f) + EPS);
                        *(GAS unsigned long long*)(AB + off) = (unsigned long long)pk2(o.x * r * gs.x, o.y * r * gs.y) | ((unsigned long long)pk2(o.z * r * gs.z, o.w * r * gs.w) << 32);
                    }
                }
            }
            GSYNC();
        }
        {
            pg8::Gemm g{AB, (const bf16*)(ws + (L == 0 ? WS_WO_A : WS_WO_B)), M, D, D}; pg8::StaticOrder S; S.init(M, D, G, bx);
            { pg8::EpiRes2<true, false, true> E{(const void*)XB, nullptr, XB, SS + (L == 0 ? 0 : 2 * M), D}; pg8::gemm_phase<pg8::EpiRes2<true, false, true>, pg8::StaticOrder, true, true>(lds, g, S, E); }
        }
        GSYNC();
        {
            pg8::Gemm g{XB, (const bf16*)(ws + (L == 0 ? WS_WGU_A : WS_WGU_B)), M, 2 * FF, D}; pg8::StaticOrder S; S.init(M, 2 * FF, G, bx);
            pg8::EpiSwiglu E{ACT, FF, SS + (L == 0 ? 0 : 2 * M), (1.0f / D) * (1.0f / 16777216.0f), EPS};
            pg8::gemm_phase<pg8::EpiSwiglu, pg8::StaticOrder, true, true>(lds, g, S, E);
            if constexpr (L == 0) {
                if (G == 256 && bx >= 128) {
                    const int t_ = opaque_tid(), lane = t_ & 63, wave = __builtin_amdgcn_readfirstlane(t_ >> 6);
                    LAS float* scr = (LAS float*)(lds + wave * 16384);
                    for (int it = (bx - 128) * NWAVES + wave; it < 32 * 352; it += 128 * NWAVES) transpose_item(argp()->in[20], D, 2 * FF, (bf16*)(ws + WS_WGU_B), 0, 1, argp()->in[19], scr, it, lane);
                }
            } else {
                if (G == 256 && bx >= 128) {
                    const int t_ = opaque_tid(), lane = t_ & 63, wave = __builtin_amdgcn_readfirstlane(t_ >> 6);
                    LAS float* scr = (LAS float*)(lds + wave * 16384);
                    for (int it = (bx - 128) * NWAVES + wave; it < 88 * 64; it += 128 * NWAVES) transpose_item(argp()->in[21], FF, D, (bf16*)(ws + WS_WD_B), 0, 0, nullptr, scr, it, lane);
                }
            }
        }
        GSYNC();
        {
            pg8::Gemm g{ACT, (const bf16*)(ws + (L == 0 ? WS_WD_A : WS_WD_B)), M, D, FF}; pg8::StaticOrder S; S.init(M, D, G, bx);
            if constexpr (L == 0) { pg8::EpiRes2<true, false, true> E{(const void*)XB, nullptr, XB, SS + M, D}; pg8::gemm_phase<pg8::EpiRes2<true, false, true>, pg8::StaticOrder, true, true>(lds, g, S, E); }
            else { pg8::EpiRes2<true, true, false> E{(const void*)XB, out, nullptr, nullptr, D}; pg8::gemm_phase<pg8::EpiRes2<true, true, false>, pg8::StaticOrder, true, true>(lds, g, S, E); }
        }
        if (L == 0) GSYNC();
}

__global__ void __launch_bounds__(NWAVES * 64, 2) fwd_megakernel(Args args) {
    extern __shared__ __attribute__((aligned(16))) unsigned char lds_raw[];
    LAS unsigned char* lds = (LAS unsigned char*)lds_raw;
    volatile LAS unsigned* MISC = (volatile LAS unsigned*)(lds + MISC_OFF);
    const int tid = threadIdx.x, lane = tid & 63, wave = __builtin_amdgcn_readfirstlane(tid >> 6);
    const int G = gridDim.x; const int bx = blockIdx.x;
    const int vcu = (G % 8 == 0) ? (bx % 8) * (G / 8) + bx / 8 : bx;
    const int gw = vcu * NWAVES + wave, NGW = G * NWAVES;
    unsigned char* ws = argp()->ws;
    gu32* ctl = (gu32*)(ws + WS_CTL);
    const float* x = argp()->in[0]; float* out = argp()->out;
    bf16* AB = (bf16*)(ws + WS_AB); bf16* P0 = (bf16*)(ws + WS_P0); bf16* P1 = (bf16*)(ws + WS_P1); bf16* P2 = (bf16*)(ws + WS_P2);
    bf16* ACT = (bf16*)(ws + WS_ACT); bf16* OB = (bf16*)(ws + WS_OB); float* ROPE = (float*)(ws + WS_ROPE);
    for (int u = tid; u < (LDS_BYTES - LDSCTL_OFF) / 4; u += NWAVES * 64) ((LAS unsigned*)(lds + LDSCTL_OFF))[u] = 0u;
    __syncthreads();
    for (unsigned u = (unsigned)(bx * NWAVES * 64 + tid); u < CTL_ZERO_BYTES / 4; u += (unsigned)(G * NWAVES * 64)) ctl[u] = 0u;


    {
        LAS float* scr = (LAS float*)(lds + wave * 16384);
        constexpr int I_QKV = 32 * 192, I_O = 32 * 64, I_GU = 32 * 352, I_D = 88 * 64, I_KV = 32 * 128;
        constexpr int NITEMS = I_QKV + 3 * I_O + 2 * I_GU + 2 * I_D + I_KV;
        for (int it = gw; it < NITEMS; it += NGW) {
            int r = it;
            if (r < I_O)   { transpose_item(argp()->in[3], D, D, (bf16*)(ws + WS_WO_A), 0, 0, nullptr, scr, r, lane); continue; } r -= I_O;
            if (r < I_GU)  { transpose_item(argp()->in[5], D, 2 * FF, (bf16*)(ws + WS_WGU_A), 0, 1, argp()->in[4], scr, r, lane); continue; } r -= I_GU;
            if (r < I_D)   { transpose_item(argp()->in[6], FF, D, (bf16*)(ws + WS_WD_A), 0, 0, nullptr, scr, r, lane); continue; } r -= I_D;
            if (r < I_KV)  { transpose_item(argp()->in[8], D, 2 * D, (bf16*)(ws + WS_WKVQ), 0, 0, argp()->in[7], scr, r, lane); continue; } r -= I_KV;
            if (r < I_O)   { transpose_item(argp()->in[11], D, D, (bf16*)(ws + WS_WKVQ), 2 * D, 0, argp()->in[10], scr, r, lane); continue; } r -= I_O;
            if (r < I_O)   { transpose_item(argp()->in[18], D, D, (bf16*)(ws + WS_WO_B), 0, 0, nullptr, scr, r, lane); continue; } r -= I_O;
            if (r < I_GU)  { if (G != 256) transpose_item(argp()->in[20], D, 2 * FF, (bf16*)(ws + WS_WGU_B), 0, 1, argp()->in[19], scr, r, lane); continue; } r -= I_GU;
            if (r < I_D)   { if (G != 256) transpose_item(argp()->in[21], FF, D, (bf16*)(ws + WS_WD_B), 0, 0, nullptr, scr, r, lane); continue; } r -= I_D;
            transpose_item(argp()->in[2], D, NPROJ, (bf16*)(ws + WS_WQKV_A), 0, 0, argp()->in[1], scr, r, lane);
        }
        xb_rows(x, (bf16*)(ws + WS_XB), (unsigned long long*)(ws + WS_SS) + 3 * (size_t)M, gw, NGW, lane);
        for (int e = (vcu * NWAVES * 64 + tid); e < SEQ * 64; e += G * NWAVES * 64) {
            const int pos = e >> 6, i = e & 63;
            const float inv_freq = powf(10000.0f, -(float)i * (1.0f / 64.0f));
            const float ang = (float)pos * inv_freq;
            const double rev = (double)ang * 0.15915494309189535;
            const float fr = (float)(rev - __builtin_rint(rev));
            ROPE[2 * e] = __builtin_amdgcn_cosf(fr); ROPE[2 * e + 1] = __builtin_amdgcn_sinf(fr);
        }
    }
    cg::this_grid().sync();
    (void)xcd_barrier_post((unsigned*)(ctl + CW_BAR), MISC + 8);

    layer_body<0>(lds, ws, x, out, G, bx, vcu, gw, NGW);
    layer_body<1>(lds, ws, x, out, G, bx, vcu, gw, NGW);
}

extern "C" void kernel_launch(void* const* d_in, const int* in_sizes, int n_in, void* d_out, int out_size, void* d_ws, size_t ws_size, hipStream_t stream) {
    static int grid = 0;
    if (grid == 0) {
        if (n_in != 22 || in_sizes[0] != M * D || out_size != M * D || ws_size < WS_END) { fprintf(stderr, "kernel_launch: unexpected problem shape / workspace (n_in %d, in0 %d, out %d, ws %zu)\n", n_in, n_in > 0 ? in_sizes[0] : -1, out_size, ws_size); grid = -1; return; }
        int dev = 0, cus = 0, per_cu = 0;
        if (hipGetDevice(&dev) != hipSuccess || hipDeviceGetAttribute(&cus, hipDeviceAttributeMultiprocessorCount, dev) != hipSuccess) { grid = -1; return; }
        if (hipFuncSetAttribute((const void*)fwd_megakernel, hipFuncAttributeMaxDynamicSharedMemorySize, LDS_BYTES) != hipSuccess) { fprintf(stderr, "kernel_launch: hipFuncSetAttribute failed\n"); grid = -1; return; }
        if (hipOccupancyMaxActiveBlocksPerMultiprocessor(&per_cu, (const void*)fwd_megakernel, NWAVES * 64, LDS_BYTES) != hipSuccess || per_cu < 1) { fprintf(stderr, "kernel_launch: occupancy query says %d blocks per CU\n", per_cu); (void)hipGetLastError(); per_cu = 1; }
        grid = cus;
    }
    if (grid < 0) return;
    Args a{};
    for (int i = 0; i < 22; ++i) a.in[i] = (const float*)d_in[i];
    a.out = (float*)d_out; a.ws = (unsigned char*)d_ws;
    void* kargs[] = {&a};
    const hipError_t e = hipLaunchCooperativeKernel((const void*)fwd_megakernel, dim3(grid), dim3(NWAVES * 64), kargs, LDS_BYTES, stream);
    if (e != hipSuccess) fprintf(stderr, "kernel_launch: cooperative launch failed: %s (grid %d)\n", hipGetErrorString(e), grid);
}
```
